# Optimizing an MI355X kernel written in HIP

```python
import math
import jax
import jax.numpy as jnp
from jax import lax
import numpy as np

D_MODEL = 1024
BATCH = 8
SEQ = 8192
DEPTH = 2

GRID_W = 64
CTX_LEN = 256
N_MIXERS = 2
EPS = 1e-6
MOD_CHUNKS = 6

HY_SHORT = 3
HY_BANDS = 16
HY_EMB_DIM = 1 + 2 * HY_BANDS
HY_FILTER_HIDDEN = 64
HY_DECAY_TARGET = 1e-2
HY_FAST_DECAY_PCT = 0.3
HY_SLOW_DECAY_PCT = 1.5
HY_MAX_DECAY = math.log(HY_DECAY_TARGET) / HY_FAST_DECAY_PCT
HY_MIN_DECAY = math.log(HY_DECAY_TARGET) / HY_SLOW_DECAY_PCT

N_HEADS = 16
N_KV_HEADS = 4
GROUP = N_HEADS // N_KV_HEADS
HEAD_DIM = D_MODEL // N_HEADS
Q_WIDTH = N_HEADS * HEAD_DIM
KV_WIDTH = N_KV_HEADS * HEAD_DIM
QKV_WIDTH = Q_WIDTH + 2 * KV_WIDTH
WINDOW = 128
BLOCK = 128
ROPE_BASE = 10000.0
ROPE_AXIS_DIM = HEAD_DIM // 2
ROPE_NFREQ = ROPE_AXIS_DIM // 2
ATTN_SCALE = HEAD_DIM ** -0.5

D_FF = 4 * D_MODEL

kernel_name = 'hybrid_hyena_swa_sink_dit'


def _rmsnorm(x, g):
    xf = x.astype(jnp.float32)
    y = xf * lax.rsqrt(jnp.mean(xf * xf, axis=-1, keepdims=True) + EPS)
    return (y * g.astype(jnp.float32)).astype(x.dtype)


def _modulate(h, shift, scale):
    return h * (1 + scale) + shift


def _mlp(h, w1, w2):
    return jnp.square(jax.nn.relu(h @ w1)) @ w2


def _short_conv(x, w, b):
    L = x.shape[1]
    pad = HY_SHORT // 2
    xp = jnp.pad(x, ((0, 0), (pad, HY_SHORT - 1 - pad), (0, 0)))
    out = b
    for k in range(HY_SHORT):
        out = out + xp[:, k:k + L] * w[k]
    return out


def _hyena_kernel(L, w1, b1, fr1, w2, b2, fr2, w3):
    f32 = jnp.float32
    pos = jnp.arange(L, dtype=f32)
    t = pos / L
    bands = jnp.linspace(1e-4, HY_BANDS - 1, HY_BANDS, dtype=f32)
    ang = (2.0 * math.pi / L) * pos[:, None] * bands[None, :]
    z = jnp.concatenate([t[:, None], jnp.cos(ang), -jnp.sin(ang)], axis=-1)
    h = jnp.sin(fr1.astype(f32) * (z @ w1.astype(f32) + b1.astype(f32)))
    h = jnp.sin(fr2.astype(f32) * (h @ w2.astype(f32) + b2.astype(f32)))
    h = h @ w3.astype(f32)
    deltas = jnp.abs(jnp.linspace(HY_MIN_DECAY, HY_MAX_DECAY, D_MODEL, dtype=f32))
    decay = jnp.exp(-t[:, None] * deltas[None, :])
    h_fwd = h[:, :D_MODEL] * decay
    h_bwd = h[:, D_MODEL:] * decay
    kc = jnp.concatenate([h_fwd, jnp.zeros((1, D_MODEL), f32), h_bwd[:0:-1]], axis=0)
    return kc / jnp.sum(jnp.abs(kc), axis=0, keepdims=True)


def _hyena_mixer(h, w_in, b_in, conv_w, conv_b, f_w1, f_b1, f_fr1, f_w2, f_b2, f_fr2, f_w3,
                 skip, w_out, b_out):
    L = h.shape[1]
    proj = _short_conv(h @ w_in + b_in, conv_w, conv_b)
    x0, x1, v = jnp.split(proj, 3, axis=-1)
    u = (x1 * v).astype(jnp.float32)
    kc = _hyena_kernel(L, f_w1, f_b1, f_fr1, f_w2, f_b2, f_fr2, f_w3)
    U = jnp.fft.rfft(u, n=2 * L, axis=1)
    K = jnp.fft.rfft(kc, axis=0)
    y = jnp.fft.irfft(U * K[None], n=2 * L, axis=1)[:, :L] + u * skip.astype(jnp.float32)
    y = x0 * y.astype(h.dtype)
    return y @ w_out + b_out


def _axial_rope_tables(L):
    rows = L // GRID_W
    row = jnp.repeat(jnp.arange(rows, dtype=jnp.float32), GRID_W)
    col = jnp.tile(jnp.arange(GRID_W, dtype=jnp.float32), rows)
    inv = ROPE_BASE ** (-jnp.arange(ROPE_NFREQ, dtype=jnp.float32) / ROPE_NFREQ)
    ang_r = row[:, None] * inv[None, :]
    ang_c = col[:, None] * inv[None, :]
    return jnp.cos(ang_r), jnp.sin(ang_r), jnp.cos(ang_c), jnp.sin(ang_c)


def _rotate(x, cos, sin):
    x1 = x[..., :ROPE_NFREQ]
    x2 = x[..., ROPE_NFREQ:]
    cs = cos[None, :, None, :]
    sn = sin[None, :, None, :]
    return jnp.concatenate([x1 * cs - x2 * sn, x2 * cs + x1 * sn], axis=-1)


def _apply_axial_rope(x, tables):
    cr, sr, cc, sc = tables
    xf = x.astype(jnp.float32)
    out = jnp.concatenate([_rotate(xf[..., :ROPE_AXIS_DIM], cr, sr),
                           _rotate(xf[..., ROPE_AXIS_DIM:], cc, sc)], axis=-1)
    return out.astype(x.dtype)


def _qkv(h, w, b, qn, kn, with_q):
    B, L, _ = h.shape
    if with_q:
        qkv = h @ w + b
        q, k, v = jnp.split(qkv, [Q_WIDTH, Q_WIDTH + KV_WIDTH], axis=-1)
        q = _rmsnorm(q.reshape(B, L, N_HEADS, HEAD_DIM), qn)
    else:
        kv = h @ w[:, Q_WIDTH:] + b[Q_WIDTH:]
        k, v = jnp.split(kv, 2, axis=-1)
        q = None
    k = _rmsnorm(k.reshape(B, L, N_KV_HEADS, HEAD_DIM), kn)
    v = v.reshape(B, L, N_KV_HEADS, HEAD_DIM)
    return q, k, v


def _sink_softmax(scores, sink):
    s = jnp.broadcast_to(sink[None, :, :, None, None], scores.shape[:-1] + (1,))
    p = jax.nn.softmax(jnp.concatenate([scores, s], axis=-1), axis=-1)
    return p[..., :-1]


def _context_attention(qc, kc, vc, sink):
    B, Lc = qc.shape[:2]
    qg = qc.reshape(B, Lc, N_KV_HEADS, GROUP, HEAD_DIM)
    s = jnp.einsum('bqhgd,bkhd->bhgqk', qg, kc, preferred_element_type=jnp.float32) * ATTN_SCALE
    p = _sink_softmax(s, sink)
    o = jnp.einsum('bhgqk,bkhd->bqhgd', p.astype(vc.dtype), vc)
    return o.reshape(B, Lc, Q_WIDTH)


def _latent_window_attention(q, k, v, kc, vc, sink):
    B, L = q.shape[:2]
    Lc = kc.shape[1]
    nb = L // BLOCK
    span = BLOCK + 2 * WINDOW
    qg = q.reshape(B, L, N_KV_HEADS, GROUP, HEAD_DIM)
    kp = jnp.pad(k, ((0, 0), (WINDOW, WINDOW), (0, 0), (0, 0)))
    vp = jnp.pad(v, ((0, 0), (WINDOW, WINDOW), (0, 0), (0, 0)))
    rel = jnp.arange(span)[None, :] - WINDOW - jnp.arange(BLOCK)[:, None]
    band = jnp.abs(rel) <= WINDOW

    def one_block(b):
        start = b * BLOCK
        qb = lax.dynamic_slice_in_dim(qg, start, BLOCK, axis=1)
        kb = lax.dynamic_slice_in_dim(kp, start, span, axis=1)
        vb = lax.dynamic_slice_in_dim(vp, start, span, axis=1)
        kpos = start - WINDOW + jnp.arange(span)
        valid = band & ((kpos >= 0) & (kpos < L))[None, :]
        s_w = jnp.einsum('bqhgd,bkhd->bhgqk', qb, kb, preferred_element_type=jnp.float32) * ATTN_SCALE
        s_w = jnp.where(valid, s_w, -jnp.inf)
        s_c = jnp.einsum('bqhgd,bkhd->bhgqk', qb, kc, preferred_element_type=jnp.float32) * ATTN_SCALE
        p = _sink_softmax(jnp.concatenate([s_w, s_c], axis=-1), sink)
        p_w = p[..., :span].astype(vb.dtype)
        p_c = p[..., span:span + Lc].astype(vc.dtype)
        o = (jnp.einsum('bhgqk,bkhd->bqhgd', p_w, vb)
             + jnp.einsum('bhgqk,bkhd->bqhgd', p_c, vc))
        return o.reshape(B, BLOCK, Q_WIDTH)

    out = lax.map(one_block, jnp.arange(nb))
    return jnp.transpose(out, (1, 0, 2, 3)).reshape(B, L, Q_WIDTH)


def setup_inputs(seed: int = 0) -> dict:
    key = jax.random.key(seed)
    ks = jax.random.split(key, 40)
    n_hy = (DEPTH + N_MIXERS - 1) // N_MIXERS
    n_at = DEPTH // N_MIXERS
    f32 = jnp.float32

    def nrm(i, shape, scale):
        return jax.random.normal(ks[i], shape, f32) * scale

    return {
        'x': nrm(0, (BATCH, SEQ, D_MODEL), 1.0),
        'c': nrm(1, (BATCH, D_MODEL), 1.0),
        'ctx': nrm(2, (BATCH, CTX_LEN, D_MODEL), 1.0),
        'c_ctx': nrm(3, (D_MODEL,), 1.0),
        'mod_w': nrm(4, (DEPTH, D_MODEL, MOD_CHUNKS * D_MODEL), 0.5 * D_MODEL ** -0.5),
        'mod_b': nrm(5, (DEPTH, MOD_CHUNKS * D_MODEL), 0.02),
        'norm1_w': 1.0 + nrm(6, (DEPTH, D_MODEL), 0.1),
        'norm2_w': 1.0 + nrm(7, (DEPTH, D_MODEL), 0.1),
        'mlp_w1': nrm(8, (DEPTH, D_MODEL, D_FF), D_MODEL ** -0.5),
        'mlp_w2': nrm(9, (DEPTH, D_FF, D_MODEL), D_FF ** -0.5),
        'hy_w_in': nrm(10, (n_hy, D_MODEL, 3 * D_MODEL), D_MODEL ** -0.5),
        'hy_b_in': nrm(11, (n_hy, 3 * D_MODEL), 0.02),
        'hy_conv_w': nrm(12, (n_hy, HY_SHORT, 3 * D_MODEL), HY_SHORT ** -0.5),
        'hy_conv_b': nrm(13, (n_hy, 3 * D_MODEL), 0.02),
        'hy_f_w1': nrm(14, (n_hy, HY_EMB_DIM, HY_FILTER_HIDDEN), HY_EMB_DIM ** -0.5),
        'hy_f_b1': nrm(15, (n_hy, HY_FILTER_HIDDEN), 0.2),
        'hy_f_freq1': 1.0 + nrm(16, (n_hy, HY_FILTER_HIDDEN), 0.01),
        'hy_f_w2': nrm(17, (n_hy, HY_FILTER_HIDDEN, HY_FILTER_HIDDEN), HY_FILTER_HIDDEN ** -0.5),
        'hy_f_b2': nrm(18, (n_hy, HY_FILTER_HIDDEN), 0.2),
        'hy_f_freq2': 1.0 + nrm(19, (n_hy, HY_FILTER_HIDDEN), 0.01),
        'hy_f_w3': nrm(20, (n_hy, HY_FILTER_HIDDEN, 2 * D_MODEL), HY_FILTER_HIDDEN ** -0.5),
        'hy_skip': nrm(21, (n_hy, D_MODEL), 1.0),
        'hy_w_out': nrm(22, (n_hy, D_MODEL, D_MODEL), D_MODEL ** -0.5),
        'hy_b_out': nrm(23, (n_hy, D_MODEL), 0.02),
        'at_w_qkv': nrm(24, (n_at, D_MODEL, QKV_WIDTH), D_MODEL ** -0.5),
        'at_b_qkv': nrm(25, (n_at, QKV_WIDTH), 0.02),
        'at_q_norm': 1.0 + nrm(26, (n_at, HEAD_DIM), 0.1),
        'at_k_norm': 1.0 + nrm(27, (n_at, HEAD_DIM), 0.1),
        'at_sink': nrm(28, (n_at, N_HEADS), 0.5),
        'at_w_out': nrm(29, (n_at, Q_WIDTH, D_MODEL), Q_WIDTH ** -0.5),
        'at_b_out': nrm(30, (n_at, D_MODEL), 0.02),
    }


def reference(x, c, ctx, c_ctx, mod_w, mod_b, norm1_w, norm2_w, mlp_w1, mlp_w2,
              hy_w_in, hy_b_in, hy_conv_w, hy_conv_b, hy_f_w1, hy_f_b1, hy_f_freq1,
              hy_f_w2, hy_f_b2, hy_f_freq2, hy_f_w3, hy_skip, hy_w_out, hy_b_out,
              at_w_qkv, at_b_qkv, at_q_norm, at_k_norm, at_sink, at_w_out, at_b_out):
    L = x.shape[1]
    rope_tables = _axial_rope_tables(L)
    for i in range(DEPTH):
        last = i == DEPTH - 1
        kind = i % N_MIXERS
        j = i // N_MIXERS
        need_ctx = (not last) or kind == 1
        mod = jax.nn.silu(c) @ mod_w[i] + mod_b[i]
        m = jnp.split(mod[:, None, :], MOD_CHUNKS, axis=-1)
        hx = _modulate(_rmsnorm(x, norm1_w[i]), m[0], m[1])
        if need_ctx:
            mod_c = jax.nn.silu(c_ctx) @ mod_w[i] + mod_b[i]
            mc = jnp.split(mod_c[None, None, :], MOD_CHUNKS, axis=-1)
            hc = _modulate(_rmsnorm(ctx, norm1_w[i]), mc[0], mc[1])
        if kind == 0:
            hp = (hy_w_in[j], hy_b_in[j], hy_conv_w[j], hy_conv_b[j], hy_f_w1[j], hy_f_b1[j],
                  hy_f_freq1[j], hy_f_w2[j], hy_f_b2[j], hy_f_freq2[j], hy_f_w3[j], hy_skip[j],
                  hy_w_out[j], hy_b_out[j])
            dx = _hyena_mixer(hx, *hp)
            if not last:
                dc = _hyena_mixer(hc, *hp)
        else:
            sink = at_sink[j].astype(jnp.float32).reshape(N_KV_HEADS, GROUP)
            qx, kx, vx = _qkv(hx, at_w_qkv[j], at_b_qkv[j], at_q_norm[j], at_k_norm[j], True)
            qx = _apply_axial_rope(qx, rope_tables)
            kx = _apply_axial_rope(kx, rope_tables)
            qc, kc, vc = _qkv(hc, at_w_qkv[j], at_b_qkv[j], at_q_norm[j], at_k_norm[j], not last)
            dx = _latent_window_attention(qx, kx, vx, kc, vc, sink) @ at_w_out[j] + at_b_out[j]
            if not last:
                dc = _context_attention(qc, kc, vc, sink) @ at_w_out[j] + at_b_out[j]
        x = x + m[2] * dx
        x = x + m[5] * _mlp(_modulate(_rmsnorm(x, norm2_w[i]), m[3], m[4]), mlp_w1[i], mlp_w2[i])
        if not last:
            ctx = ctx + mc[2] * dc
            ctx = ctx + mc[5] * _mlp(_modulate(_rmsnorm(ctx, norm2_w[i]), mc[3], mc[4]),
                                     mlp_w1[i], mlp_w2[i])
    return x
```

```cpp
#include <hip/hip_runtime.h>
#include <hip/hip_cooperative_groups.h>
#include <cstdio>
namespace cg = cooperative_groups;

#define DI __device__ __forceinline__
#define LAS __attribute__((address_space(3)))
typedef unsigned short bf16_t;
typedef short bf16x8 __attribute__((ext_vector_type(8)));
typedef short s16x4 __attribute__((ext_vector_type(4)));
typedef float f32x4 __attribute__((ext_vector_type(4)));
typedef float f32x16 __attribute__((ext_vector_type(16)));
typedef unsigned u32x4 __attribute__((ext_vector_type(4)));
typedef unsigned u32x2 __attribute__((ext_vector_type(2)));
typedef __bf16 bf2_t __attribute__((ext_vector_type(2)));
typedef float f2_t __attribute__((ext_vector_type(2)));

constexpr int NB = 8, SEQ = 8192, DM = 1024, CL = 256, TX = NB * SEQ, TC = NB * CL, TT = TX + TC, DFF = 4096;
constexpr int LDS_XB = 128 * 129 * 8;
constexpr int LDS_SPARE = LDS_XB + 16;
constexpr int LDS_SRC0 = LDS_SPARE + 2 * 4096;
constexpr int LDS_BYTES = LDS_SRC0 + 8 * 2048;
constexpr float EPS = 1e-6f;
constexpr float LOG2E = 1.4426950408889634f;

constexpr size_t MiB = 1024 * 1024;
constexpr size_t OFF_WIN = 0;
constexpr size_t OFF_WHO = OFF_WIN + 6 * MiB;
constexpr size_t OFF_W1 = OFF_WHO + 2 * MiB;
constexpr size_t OFF_W2 = OFF_W1 + 16 * MiB;
constexpr size_t OFF_WQKV = OFF_W2 + 16 * MiB;
constexpr size_t OFF_WAO = OFF_WQKV + 3 * MiB;
constexpr size_t OFF_MOD = OFF_WAO + 2 * MiB;
constexpr size_t OFF_H2 = OFF_MOD + MiB / 2;
constexpr size_t OFF_H2C = OFF_H2 + 2 * MiB;
constexpr size_t OFF_NORM = OFF_H2C + 65536;
constexpr size_t OFF_XBAR = OFF_NORM + 16384;
constexpr size_t OFF_KCU = OFF_NORM + 65536;
constexpr size_t OFF_KCUC = OFF_KCU + 64 * MiB;
constexpr size_t OFF_KSCR = OFF_KCUC + 2 * MiB;
constexpr size_t OFF_CX = OFF_KSCR + 34 * MiB;
constexpr size_t OFF_HBUF = OFF_CX + 8 * MiB;
constexpr size_t OFF_UT = OFF_HBUF + 132 * MiB;
constexpr size_t OFF_UTC = OFF_UT + 128 * MiB;
constexpr size_t OFF_BIG = OFF_UTC + 4 * MiB;
constexpr size_t OFF_X0C = OFF_BIG + 396 * MiB;
constexpr size_t OFF_SSQ = OFF_BIG + 528 * MiB;
constexpr size_t OFF_SW = OFF_SSQ + MiB;
constexpr size_t OFF_SSQP = OFF_SW + MiB;
constexpr size_t WS_END = OFF_SSQP + 13 * MiB;

struct P {
    const float *x, *c, *ctx, *c_ctx, *mod_w, *mod_b, *norm1_w, *norm2_w, *mlp_w1, *mlp_w2, *hy_w_in, *hy_b_in, *hy_conv_w, *hy_conv_b, *hy_f_w1, *hy_f_b1, *hy_f_fr1, *hy_f_w2,
        *hy_f_b2, *hy_f_fr2, *hy_f_w3, *hy_skip, *hy_w_out, *hy_b_out, *at_w_qkv, *at_b_qkv, *at_q_norm, *at_k_norm, *at_sink, *at_w_out, *at_b_out;
    float* out;
    unsigned char* ws;
};

DI unsigned pk2(float lo, float hi) { f2_t v = {lo, hi}; bf2_t r = __builtin_convertvector(v, bf2_t); return __builtin_bit_cast(unsigned, r); }
DI float bf_lo(unsigned u) { return __uint_as_float(u << 16); }
DI float bf_hi(unsigned u) { return __uint_as_float(u & 0xffff0000u); }
DI float bf1(bf16_t b) { return __uint_as_float(((unsigned)b) << 16); }
DI bf16_t f2bf(float f) { return (bf16_t)(pk2(f, 0.f) & 0xffffu); }
DI float wave_sum(float v) {
#pragma unroll
    for (int o = 1; o < 64; o <<= 1) v += __shfl_xor(v, o);
    return v;
}
template <int CTRL> DI float dpp_mov(float v) { return __builtin_bit_cast(float, __builtin_amdgcn_update_dpp(0, __builtin_bit_cast(int, v), CTRL, 0xF, 0xF, true)); }
DI int otid() { int t = threadIdx.x; asm volatile("" : "+v"(t)); return t; }
DI void unpack8(const u32x4 w, float (&f)[8]) { f[0] = bf_lo(w.x); f[1] = bf_hi(w.x); f[2] = bf_lo(w.y); f[3] = bf_hi(w.y); f[4] = bf_lo(w.z); f[5] = bf_hi(w.z); f[6] = bf_lo(w.w); f[7] = bf_hi(w.w); }
DI u32x4 pack8(const float (&f)[8]) { u32x4 w; w.x = pk2(f[0], f[1]); w.y = pk2(f[2], f[3]); w.z = pk2(f[4], f[5]); w.w = pk2(f[6], f[7]); return w; }

#define XB_TMO      128
#define XB_XCNT(j)  (256  + 64 * (j))
#define XB_XSUB(j)  (1280 + 64 * (j))
#define XB_XGEN(j)  (2304 + 64 * (j))
#define XB_TOP      3328
#define XB_TOPGEN   3392
#define XCD_BAR_WORDS 3456
#define XB_SPIN_CAP (1u << 18)
DI unsigned xb_ld(unsigned* p)              { return __hip_atomic_load(p, __ATOMIC_RELAXED, __HIP_MEMORY_SCOPE_AGENT); }
DI unsigned xb_add(unsigned* p, unsigned v) { return __hip_atomic_fetch_add(p, v, __ATOMIC_RELAXED, __HIP_MEMORY_SCOPE_AGENT); }
DI unsigned xb_xcc_id() { return (unsigned)__builtin_amdgcn_s_getreg((3 << 11) | 20) & 0xFu; }
#define XB_SPIN(cond, bar) do { unsigned _sp = 0; while (cond) { __builtin_amdgcn_s_sleep(1); \
    if ((++_sp & 255u) == 0u) { if (xb_ld(&(bar)[XB_TMO])) break; if (_sp > XB_SPIN_CAP) { atomicAdd(&(bar)[XB_TMO], 1u); break; } } } } while (0)
struct XcdBarrier { unsigned* bar; unsigned x; volatile LAS unsigned* st; };
DI XcdBarrier xcd_barrier_post(unsigned* bar, volatile LAS unsigned* st) {
    XcdBarrier b; b.bar = bar; b.x = xb_xcc_id(); b.st = st;
    if (threadIdx.x == 0) (void)xb_add(&bar[XB_XCNT(b.x)], 1u);
    return b;
}
DI void xcd_barrier_complete(unsigned* bar, unsigned x, unsigned& nloc, unsigned& nx) {
    const unsigned G = gridDim.x * gridDim.y * gridDim.z;
    unsigned sum, cnt, mine, sp = 0u;
    for (;;) {
        sum = 0u; cnt = 0u; mine = 0u;
#pragma unroll
        for (unsigned j = 0; j < 16; ++j) { const unsigned c = xb_ld(&bar[XB_XCNT(j)]); sum += c; cnt += (c > 0u) ? 1u : 0u; mine = (j == x) ? c : mine; }
        if (sum == G) break;
        __builtin_amdgcn_s_sleep(1);
        if ((++sp & 255u) == 0u) { if (xb_ld(&bar[XB_TMO])) break; if (sp > XB_SPIN_CAP) { atomicAdd(&bar[XB_TMO], 1u); break; } }
    }
    nloc = mine > 0u ? mine : 1u; nx = cnt > 0u ? cnt : 1u;
}
DI void xcd_barrier(const XcdBarrier& b) {
    asm volatile("s_waitcnt vmcnt(0)" ::: "memory");
    __syncthreads();
    if (threadIdx.x == 0) {
        unsigned* bar = b.bar;
        __builtin_amdgcn_s_waitcnt(0);
        unsigned nloc = b.st[0], nx = b.st[1];
        if (nloc == 0u) { xcd_barrier_complete(bar, b.x, nloc, nx); b.st[0] = nloc; b.st[1] = nx; }
        const unsigned old = xb_add(&bar[XB_XSUB(b.x)], 1u);
        const unsigned gen = old / nloc;
        if (old + 1u == (gen + 1u) * nloc) {
            __builtin_amdgcn_fence(__ATOMIC_RELEASE, "agent");
            asm volatile("s_waitcnt vmcnt(0)" ::: "memory");
            const unsigned og = xb_add(&bar[XB_TOP], 1u);
            const unsigned tg = og / nx;
            if (og + 1u == (tg + 1u) * nx) xb_add(&bar[XB_TOPGEN], 1u);
            else XB_SPIN(xb_ld(&bar[XB_TOPGEN]) == tg, bar);
            __builtin_amdgcn_fence(__ATOMIC_ACQUIRE, "agent");
            xb_add(&bar[XB_XGEN(b.x)], 1u);
            asm volatile("s_waitcnt vmcnt(0)" ::: "memory");
        } else {
            XB_SPIN(xb_ld(&bar[XB_XGEN(b.x)]) == gen, bar);
            __builtin_amdgcn_fence(__ATOMIC_ACQUIRE, "agent");
            asm volatile("s_waitcnt vmcnt(0)" ::: "memory");
        }
    }
    __syncthreads();
}

namespace pg8 {
constexpr int BM = 256, BK = 64, HALF = 128, HTB = HALF * BK * 2, STAGE_BYTES = 8 * HTB, NXCD = 8, WGM = 8;
DI int lds_byte(int r, int c) { const int st = (r >> 4) * 2 + (c >> 5), rr = r & 15, cc = c & 31, ob = rr * 64 + cc * 2; return st * 1024 + (ob ^ (((ob >> 9) & 1) << 5)); }
DI void stage_rc(int b, int& R, int& C) { const int st = b / 1024, sb = b % 1024, swz = sb ^ (((sb >> 9) & 1) << 5); R = (st >> 1) * 16 + swz / 64; C = (st & 1) * 32 + (swz % 64) / 2; }
DI int perm32(int rho) { const int n = rho >> 4, i = rho & 15; return 8 * (i >> 2) + 4 * n + (i & 3); }
struct Unit { int pm, pn; };
struct Gemm { const bf16_t* A; const bf16_t* Bt; int M, N, K; int ld; int ksplit; };
struct StaticOrder {
    int nM, nN, nwg, G, c;
    DI void init(int M, int N, int G_, int c_) { nM = M / BM; nN = N / BM; nwg = nM * nN; G = G_; c = c_; }
    DI bool next(int i, Unit& u) const {
        const long L = (long)i * G + c; if (L >= nwg) return false;
        int wgid = (int)L; { const int q = nwg / NXCD, r = nwg % NXCD, xcd = wgid % NXCD, off = wgid / NXCD; wgid = (xcd < r ? xcd * (q + 1) : r * (q + 1) + (xcd - r) * q) + off; }
        const int nig = WGM * nN, gid = wgid / nig, fm = gid * WGM, gsz = (nM - fm) < WGM ? (nM - fm) : WGM;
        u.pm = fm + ((wgid % nig) % gsz); u.pn = (wgid % nig) / gsz; return true;
    }
};
template <int ACT  , bool NORM> struct EpiBf16 {
    static constexpr bool PERM = true;
    static constexpr bool PREFETCH_SRC = false;
    static constexpr bool PREFETCH = NORM;
    bf16_t* O; int ldc; const float* bias; const float* ssq; const float* sw;
    DI void prefetch(LAS unsigned char* sp, const Unit& u, int wid, int lane) const {
        if (wid > 2) return;
        const int mi = (u.pm < (TX / BM)) ? (u.pm >> 5) : 8;
        const float* base = (wid == 0) ? sw + mi * 4096 + u.pn * BM : (wid == 1) ? ssq + u.pm * BM : ((ACT == 0) ? bias + u.pn * BM : sw);
        unsigned lo = (unsigned)lane * 16u; asm volatile("" : "+v"(lo));
        if (wid < 2 || ACT == 0) __builtin_amdgcn_global_load_lds((const unsigned*)((const char*)base + lo), (LAS unsigned*)(sp + wid * 1024), 16, 0, 0);
    }
    DI void run(const f32x4 (&acc)[2][2][4][2], const Unit& u, int wr, int wc, int fr, int fq, const LAS unsigned char* sp) const {
        const int row0 = u.pm * BM + wr * 64 + fr; const int col0 = u.pn * BM + wc * 32 + 8 * fq;
        const int lc = wc * 32 + 8 * fq, lr = wr * 64 + fr;
        f32x4 bv[2][2];
#pragma unroll
        for (int bj = 0; bj < 2; ++bj)
#pragma unroll
            for (int n = 0; n < 2; ++n) { bv[bj][n] = *(const LAS f32x4*)(sp + (lc + bj * HALF + 4 * n) * 4);
                if (ACT == 0) bv[bj][n] += *(const LAS f32x4*)(sp + 2048 + (lc + bj * HALF + 4 * n) * 4); }
#pragma unroll
        for (int ai = 0; ai < 2; ++ai)
#pragma unroll
            for (int m = 0; m < 4; ++m) { const int row = row0 + ai * HALF + m * 16; bf16_t* rowp = O + (size_t)row * ldc + col0;
                const float r = *(const LAS float*)(sp + 1024 + (lr + ai * HALF + m * 16) * 4);
#pragma unroll
                for (int bj = 0; bj < 2; ++bj) { f32x4 v0 = acc[ai][bj][m][0] * r + bv[bj][0], v1 = acc[ai][bj][m][1] * r + bv[bj][1];
                    if (ACT == 1) {
#pragma unroll
                        for (int j = 0; j < 4; ++j) { const float a = fmaxf(v0[j], 0.f), b = fmaxf(v1[j], 0.f); v0[j] = a * a; v1[j] = b * b; } }
                    u32x4 w; w.x = pk2(v0[0], v0[1]); w.y = pk2(v0[2], v0[3]); w.z = pk2(v1[0], v1[1]); w.w = pk2(v1[2], v1[3]);
                    *(u32x4*)(rowp + bj * HALF) = w; } }
    }
    DI void operator()(const f32x4 (&acc)[2][2][4][2], const Unit& u, int wr, int wc, int fr, int fq) const {
        const int row0 = u.pm * BM + wr * 64 + fr; const int col0 = u.pn * BM + wc * 32 + 8 * fq;
        const int mi = (u.pm < (TX / BM)) ? (u.pm >> 5) : 8;
        f32x4 bv[2][2];
#pragma unroll
        for (int bj = 0; bj < 2; ++bj)
#pragma unroll
            for (int n = 0; n < 2; ++n) { bv[bj][n] = (ACT == 0) ? *(const f32x4*)(bias + col0 + bj * HALF + 4 * n) : (f32x4){0.f, 0.f, 0.f, 0.f};
                if (NORM) bv[bj][n] += *(const f32x4*)(sw + mi * 4096 + col0 + bj * HALF + 4 * n); }
#pragma unroll
        for (int ai = 0; ai < 2; ++ai)
#pragma unroll
            for (int m = 0; m < 4; ++m) { const int row = row0 + ai * HALF + m * 16; bf16_t* rowp = O + (size_t)row * ldc + col0;
                const float r = NORM ? ssq[row] : 1.f;
#pragma unroll
                for (int bj = 0; bj < 2; ++bj) { f32x4 v0 = acc[ai][bj][m][0] * r + bv[bj][0], v1 = acc[ai][bj][m][1] * r + bv[bj][1];
                    if (ACT == 1) {
#pragma unroll
                        for (int j = 0; j < 4; ++j) { const float a = fmaxf(v0[j], 0.f), b = fmaxf(v1[j], 0.f); v0[j] = a * a; v1[j] = b * b; } }
                    u32x4 w; w.x = pk2(v0[0], v0[1]); w.y = pk2(v0[2], v0[3]); w.z = pk2(v1[0], v1[1]); w.w = pk2(v1[2], v1[3]);
                    *(u32x4*)(rowp + bj * HALF) = w; } }
    }
};
struct EpiBf16RowBias {
    static constexpr bool PERM = true; static constexpr bool PREFETCH = true; static constexpr bool PREFETCH_SRC = false;
    bf16_t* O; size_t ldc; const float* bias;
    DI void prefetch(LAS unsigned char* sp, const Unit& u, int wid, int lane) const {
        if (wid != 0) return;
        unsigned lo = (unsigned)lane * 16u; asm volatile("" : "+v"(lo));
        __builtin_amdgcn_global_load_lds((const unsigned*)((const char*)(bias + u.pm * BM) + lo), (LAS unsigned*)sp, 16, 0, 0);
    }
    DI void run(const f32x4 (&acc)[2][2][4][2], const Unit& u, int wr, int wc, int fr, int fq, const LAS unsigned char* sp) const {
        const int row0 = u.pm * BM + wr * 64 + fr; const int col0 = u.pn * BM + wc * 32 + 8 * fq;
#pragma unroll
        for (int ai = 0; ai < 2; ++ai)
#pragma unroll
            for (int m = 0; m < 4; ++m) { const int row = row0 + ai * HALF + m * 16; const float bs = *(const LAS float*)(sp + (wr * 64 + fr + ai * HALF + m * 16) * 4); bf16_t* rowp = O + (size_t)row * ldc + col0;
#pragma unroll
                for (int bj = 0; bj < 2; ++bj) { const f32x4 v0 = acc[ai][bj][m][0] + bs, v1 = acc[ai][bj][m][1] + bs;
                    u32x4 w; w.x = pk2(v0[0], v0[1]); w.y = pk2(v0[2], v0[3]); w.z = pk2(v1[0], v1[1]); w.w = pk2(v1[2], v1[3]);
                    *(u32x4*)(rowp + bj * HALF) = w; } }
    }
};
struct EpiPartial {
    static constexpr bool PERM = true; static constexpr bool PREFETCH = false; static constexpr bool PREFETCH_SRC = false;
    float* part; int ksplit; size_t slice;
    DI void operator()(const f32x4 (&acc)[2][2][4][2], const Unit& u, int wr, int wc, int fr, int fq) const {
        const int pn = u.pn / ksplit, ks = u.pn % ksplit;
        const int row0 = u.pm * BM + wr * 64 + fr, col0 = pn * BM + wc * 32 + 8 * fq;
        float* base = part + (size_t)ks * slice;
#pragma unroll
        for (int ai = 0; ai < 2; ++ai)
#pragma unroll
            for (int m = 0; m < 4; ++m) { float* rowp = base + (size_t)(row0 + ai * HALF + m * 16) * DM + col0;
#pragma unroll
                for (int bj = 0; bj < 2; ++bj) { *(f32x4*)(rowp + bj * HALF) = acc[ai][bj][m][0]; *(f32x4*)(rowp + bj * HALF + 4) = acc[ai][bj][m][1]; } }
    }
};
template <bool FUSE, bool SRCBF, bool DSTBF> struct EpiRes {
    static constexpr bool PERM = true; static constexpr bool PREFETCH = true; static constexpr bool PREFETCH_SRC = true;
    const void* srcX; const void* srcC; void* dstX; void* dstC; const float* bias; const float* gate;
    bf16_t* xg; const float* gw; const float* scl; float* ssq;
    DI void ld_src(const void* base, size_t off, f32x4& lo, f32x4& hi) const {
        if (SRCBF) { const u32x4 w = *(const u32x4*)((const bf16_t*)base + off); lo = (f32x4){bf_lo(w.x), bf_hi(w.x), bf_lo(w.y), bf_hi(w.y)}; hi = (f32x4){bf_lo(w.z), bf_hi(w.z), bf_lo(w.w), bf_hi(w.w)}; }
        else { lo = *(const f32x4*)((const float*)base + off); hi = *(const f32x4*)((const float*)base + off + 4); }
    }
    DI void prefetch(LAS unsigned char* sp, const Unit& u, int wid, int lane) const {
        if (wid > 3) return;
        const int mi = (u.pm < (TX / BM)) ? (u.pm >> 5) : 8;
        const float* base = (wid == 0) ? gate + mi * 6144 + u.pn * BM : (wid == 1) ? (bias ? bias : gate) + u.pn * BM : (wid == 2) ? (FUSE ? gw : gate) + u.pn * BM : (FUSE ? scl : gate) + mi * 6144 + u.pn * BM;
        unsigned lo = (unsigned)lane * 16u; asm volatile("" : "+v"(lo));
        if (wid == 0 || (wid == 1 && bias) || (wid >= 2 && FUSE)) __builtin_amdgcn_global_load_lds((const unsigned*)((const char*)base + lo), (LAS unsigned*)(sp + wid * 1024), 16, 0, 0);
    }
    DI void prefetch_src(LAS unsigned char* slot, const Unit& u, int wid, int lane) const {
        if (!SRCBF) return;
        const int wr = wid >> 2, wc = wid & 3; int fr = lane & 15, fq = lane >> 4; asm volatile("" : "+v"(fr), "+v"(fq));
        const bf16_t* src = (u.pm < (TX / BM)) ? (const bf16_t*)srcX : (const bf16_t*)srcC - (size_t)TX * DM;
        const bf16_t* p0 = src + (size_t)(u.pm * BM + wr * 64 + fr) * DM + u.pn * BM + wc * 32 + 8 * fq;
        __builtin_amdgcn_global_load_lds((const unsigned*)p0, (LAS unsigned*)slot, 16, 0, 0);
        __builtin_amdgcn_global_load_lds((const unsigned*)(p0 + HALF), (LAS unsigned*)(slot + 1024), 16, 0, 0);
    }
    DI void run(const f32x4 (&acc)[2][2][4][2], const Unit& u, int wr, int wc, int fr, int fq, const LAS unsigned char* sp, const LAS unsigned char* slot, int lane) const {
        const bool lat = u.pm < (TX / BM);
        const int mi = lat ? (u.pm >> 5) : 8;
        const void* src = lat ? srcX : (const void*)((const char*)srcC - (size_t)TX * DM * (SRCBF ? 2 : 4));
        void* dst = lat ? dstX : (void*)((char*)dstC - (size_t)TX * DM * (DSTBF ? 2 : 4));
        const int row0 = u.pm * BM + wr * 64 + fr, col0 = u.pn * BM + wc * 32 + 8 * fq;
        f32x4 gv[2][2], gb[2][2], gs[2][2];
#pragma unroll
        for (int bj = 0; bj < 2; ++bj)
#pragma unroll
            for (int n = 0; n < 2; ++n) { const int lo4 = (wc * 32 + 8 * fq + bj * HALF + 4 * n) * 4; gv[bj][n] = *(const LAS f32x4*)(sp + lo4);
                gb[bj][n] = bias ? gv[bj][n] * *(const LAS f32x4*)(sp + 1024 + lo4) : (f32x4){0.f, 0.f, 0.f, 0.f};
                if (FUSE) gs[bj][n] = *(const LAS f32x4*)(sp + 2048 + lo4) * (*(const LAS f32x4*)(sp + 3072 + lo4) + 1.f); }
        f32x4 sv[2][2];
        if (SRCBF) {
#pragma unroll
            for (int bj = 0; bj < 2; ++bj) { const u32x4 w = *(const LAS u32x4*)(slot + bj * 1024 + lane * 16);
                sv[bj][0] = (f32x4){bf_lo(w.x), bf_hi(w.x), bf_lo(w.y), bf_hi(w.y)}; sv[bj][1] = (f32x4){bf_lo(w.z), bf_hi(w.z), bf_lo(w.w), bf_hi(w.w)}; }
        } else { const size_t ro = (size_t)row0 * DM + col0;
#pragma unroll
            for (int bj = 0; bj < 2; ++bj) ld_src(src, ro + bj * HALF, sv[bj][0], sv[bj][1]); }
#pragma unroll
        for (int it = 0; it < 8; ++it) { const int ai = it >> 2, m = it & 3; const int row = row0 + ai * HALF + m * 16; const size_t ro = (size_t)row * DM + col0;
            const size_t rn = (size_t)(row0 + ((it + 1) >> 2) * HALF + ((it + 1) & 3) * 16) * DM + col0;
            float ss = 0.f;
#pragma unroll
            for (int bj = 0; bj < 2; ++bj) {
                f32x4 o[2];
#pragma unroll
                for (int n = 0; n < 2; ++n) o[n] = sv[bj][n] + gv[bj][n] * acc[ai][bj][m][n] + gb[bj][n];
                if (it + 1 < 8) ld_src(src, rn + bj * HALF, sv[bj][0], sv[bj][1]);
                const size_t eo = ro + bj * HALF;
                if (DSTBF) { u32x4 w; w.x = pk2(o[0].x, o[0].y); w.y = pk2(o[0].z, o[0].w); w.z = pk2(o[1].x, o[1].y); w.w = pk2(o[1].z, o[1].w); *(u32x4*)((bf16_t*)dst + eo) = w; }
                else { *(f32x4*)((float*)dst + eo) = o[0]; *(f32x4*)((float*)dst + eo + 4) = o[1]; }
                if (FUSE) {
#pragma unroll
                    for (int n = 0; n < 2; ++n) ss += (o[n].x * o[n].x + o[n].y * o[n].y) + (o[n].z * o[n].z + o[n].w * o[n].w);
                    const f32x4 t0 = o[0] * gs[bj][0], t1 = o[1] * gs[bj][1];
                    u32x4 w; w.x = pk2(t0.x, t0.y); w.y = pk2(t0.z, t0.w); w.z = pk2(t1.x, t1.y); w.w = pk2(t1.z, t1.w); *(u32x4*)(xg + eo) = w; }
            }
            if (FUSE) { ss += __shfl_xor(ss, 16); ss += __shfl_xor(ss, 32); if (fq == 0) ssq[(size_t)row * 16 + u.pn * 4 + wc] = ss; } }
    }
};

template <class Epi>
DI void gemm_phase(LAS unsigned char* lds, const Gemm g, const StaticOrder& S, const Epi& E) {
    const int tid = otid(), wid = __builtin_amdgcn_readfirstlane(tid >> 6), lane = tid & 63, wr = wid >> 2, wc = wid & 3, fr = lane & 15, fq = lane >> 4;
    const int K = g.K, nt = K / BK, LD = g.ld, KS = g.ksplit;
    unsigned voffA[2], voffB[2];
#pragma unroll
    for (int i = 0; i < 2; ++i) { int R, C; stage_rc(tid * 16 + i * 8192, R, C); const int Rb = Epi::PERM ? ((R & ~31) + perm32(R & 31)) : R;
        voffA[i] = (unsigned)(R * LD + C) * 2u; voffB[i] = (unsigned)(Rb * LD + C) * 2u; }
    const size_t kstep = (size_t)(BK * 2);
    const size_t hstep = (size_t)HALF * LD * 2;
    const size_t kslice = (size_t)K * 2;
    const size_t tstep = 2 * hstep;
    const unsigned ldsw = (unsigned)wid * 1024u;
    const int aoff = lds_byte(wr * 64 + fr, fq * 8), boff = lds_byte(wc * 32 + fr, fq * 8);
#define PG8_SA(b, h) (((b) * 2 + (h)) * HTB)
#define PG8_SB(b, h) ((4 + (b) * 2 + (h)) * HTB)
#define PG8_STAGE(bufoff, gbase, voff) do { _Pragma("unroll") for (int _i = 0; _i < 2; ++_i) \
        __builtin_amdgcn_global_load_lds((const unsigned*)((const char*)(gbase) + (voff)[_i]), (LAS unsigned*)(lds + (bufoff) + ldsw + _i * 8192), 16, 0, 0); } while (0)
#define PG8_LDA(dst, b, h) do { _Pragma("unroll") for (int m = 0; m < 4; ++m) _Pragma("unroll") for (int k = 0; k < 2; ++k) dst[m][k] = *(const LAS bf16x8*)(lds + PG8_SA(b, h) + aoff + m * 2048 + k * 1024); } while (0)
#define PG8_LDB(dst, b, h) do { _Pragma("unroll") for (int n = 0; n < 2; ++n) _Pragma("unroll") for (int k = 0; k < 2; ++k) dst[n][k] = *(const LAS bf16x8*)(lds + PG8_SB(b, h) + boff + n * 2048 + k * 1024); } while (0)
#define PG8_MMA(ai, bj, At, Bt) do { __builtin_amdgcn_s_setprio(1); _Pragma("unroll") for (int m = 0; m < 4; ++m) _Pragma("unroll") for (int n = 0; n < 2; ++n) _Pragma("unroll") for (int k = 0; k < 2; ++k) \
        acc[ai][bj][m][n] = __builtin_amdgcn_mfma_f32_16x16x32_bf16(Bt[n][k], At[m][k], acc[ai][bj][m][n], 0, 0, 0); __builtin_amdgcn_s_setprio(0); } while (0)
#define PG8_WAIT_V(n) asm volatile("s_waitcnt vmcnt(" #n ")" ::: "memory")
#define PG8_WAIT_L(n) asm volatile("s_waitcnt lgkmcnt(" #n ")" ::: "memory")
#define PG8_BAR __builtin_amdgcn_s_barrier()
#define PG8_SCHED __builtin_amdgcn_sched_barrier(0)
    Unit cur, nxt; int ui = 0;
    if (!S.next(0, cur)) return;
    f32x4 acc[2][2][4][2];
#pragma unroll
    for (int a = 0; a < 2; ++a)
#pragma unroll
        for (int b = 0; b < 2; ++b)
#pragma unroll
            for (int m = 0; m < 4; ++m)
#pragma unroll
                for (int n = 0; n < 2; ++n) acc[a][b][m][n] = (f32x4){0.f, 0.f, 0.f, 0.f};
    bf16x8 At[4][2], B0[2][2], B1[2][2];
    const char* cA = (const char*)g.A + (size_t)cur.pm * tstep + (size_t)(cur.pn % KS) * kslice; const char* cB = (const char*)g.Bt + (size_t)(cur.pn / KS) * tstep + (size_t)(cur.pn % KS) * kslice;
    PG8_STAGE(PG8_SB(0, 0), cB, voffB); PG8_STAGE(PG8_SA(0, 0), cA, voffA); PG8_STAGE(PG8_SB(0, 1), cB + hstep, voffB); PG8_STAGE(PG8_SA(0, 1), cA + hstep, voffA);
    if (wr == 1) PG8_BAR;
    PG8_WAIT_V(4); PG8_BAR;
    PG8_STAGE(PG8_SB(1, 0), cB + kstep, voffB); PG8_STAGE(PG8_SA(1, 0), cA + kstep, voffA); PG8_STAGE(PG8_SB(1, 1), cB + hstep + kstep, voffB);
    PG8_WAIT_V(6); PG8_BAR;
    for (;;) {
        const bool has_next = S.next(ui + 1, nxt);
        const char* nA = has_next ? (const char*)g.A + (size_t)nxt.pm * tstep + (size_t)(nxt.pn % KS) * kslice : cA; const char* nB = has_next ? (const char*)g.Bt + (size_t)(nxt.pn / KS) * tstep + (size_t)(nxt.pn % KS) * kslice : cB;
        if constexpr (Epi::PREFETCH_SRC) E.prefetch_src(lds + LDS_SRC0 + wid * 2048, cur, wid, lane);
        if constexpr (Epi::PREFETCH) E.prefetch(lds + LDS_SPARE + (ui & 1) * 4096, cur, wid, lane);
        for (int t = 0; t < nt; t += 2) {
            const bool last = (t == nt - 2);
            const char* a1 = cA + (size_t)(t + 1) * kstep;
            const char* a2 = last ? nA : cA + (size_t)(t + 2) * kstep; const char* b2 = last ? nB : cB + (size_t)(t + 2) * kstep;
            const char* a3 = a2 + kstep; const char* b3 = b2 + kstep;
            PG8_LDB(B0, 0, 0); PG8_SCHED; PG8_LDA(At, 0, 0); PG8_STAGE(PG8_SA(1, 1), a1 + hstep, voffA);
            PG8_WAIT_L(8); PG8_BAR; PG8_WAIT_L(0); PG8_MMA(0, 0, At, B0); PG8_BAR; PG8_SCHED;
            PG8_LDB(B1, 0, 1); PG8_STAGE(PG8_SB(0, 0), b2, voffB);
            PG8_BAR; PG8_WAIT_L(0); PG8_MMA(0, 1, At, B1); PG8_BAR;
            PG8_LDA(At, 0, 1); PG8_STAGE(PG8_SA(0, 0), a2, voffA);
            PG8_BAR; PG8_WAIT_L(0); PG8_MMA(1, 0, At, B0); PG8_BAR; PG8_SCHED;
            PG8_STAGE(PG8_SB(0, 1), b2 + hstep, voffB);
            PG8_WAIT_V(6); PG8_BAR; PG8_MMA(1, 1, At, B1); PG8_BAR;
            PG8_LDB(B0, 1, 0); PG8_SCHED; PG8_LDA(At, 1, 0); PG8_STAGE(PG8_SA(0, 1), a2 + hstep, voffA);
            PG8_WAIT_L(8); PG8_BAR; PG8_WAIT_L(0); PG8_MMA(0, 0, At, B0); PG8_BAR; PG8_SCHED;
            PG8_LDB(B1, 1, 1); PG8_STAGE(PG8_SB(1, 0), b3, voffB);
            PG8_BAR; PG8_WAIT_L(0); PG8_MMA(0, 1, At, B1); PG8_BAR;
            PG8_LDA(At, 1, 1); PG8_STAGE(PG8_SA(1, 0), a3, voffA);
            PG8_BAR; PG8_WAIT_L(0); PG8_MMA(1, 0, At, B0); PG8_BAR; PG8_SCHED;
            PG8_STAGE(PG8_SB(1, 1), b3 + hstep, voffB);
            PG8_WAIT_V(6); PG8_BAR; PG8_MMA(1, 1, At, B1); PG8_BAR;
        }
        if constexpr (Epi::PREFETCH_SRC) E.run(acc, cur, wr, wc, fr, fq, lds + LDS_SPARE + (ui & 1) * 4096, lds + LDS_SRC0 + wid * 2048, lane);
        else if constexpr (Epi::PREFETCH) E.run(acc, cur, wr, wc, fr, fq, lds + LDS_SPARE + (ui & 1) * 4096); else E(acc, cur, wr, wc, fr, fq);
        if (!has_next) break;
#pragma unroll
        for (int a = 0; a < 2; ++a)
#pragma unroll
            for (int b = 0; b < 2; ++b)
#pragma unroll
                for (int m = 0; m < 4; ++m)
#pragma unroll
                    for (int n = 0; n < 2; ++n) acc[a][b][m][n] = (f32x4){0.f, 0.f, 0.f, 0.f};
        cur = nxt; cA = nA; cB = nB; ++ui;
    }
    PG8_WAIT_V(0);
    if (wr == 0) PG8_BAR;
    PG8_BAR;
#undef PG8_SA
#undef PG8_SB
#undef PG8_STAGE
#undef PG8_LDA
#undef PG8_LDB
#undef PG8_MMA
#undef PG8_WAIT_V
#undef PG8_WAIT_L
#undef PG8_BAR
#undef PG8_SCHED
}
}

template <class Epi> DI void run_gemm(unsigned char* shm, const bf16_t* A, const bf16_t* Bt, int M, int N, int K, const Epi& E, int ld = 0, int ksplit = 1) {
    pg8::Gemm g; g.A = A; g.Bt = Bt; g.M = M; g.N = N; g.K = K; g.ld = ld ? ld : K; g.ksplit = ksplit;
    pg8::StaticOrder S; S.init(M, N * ksplit, (int)gridDim.x, (int)blockIdx.x);
    pg8::gemm_phase<Epi>((LAS unsigned char*)shm, g, S, E);
    __syncthreads();
}

DI void transpose_item(const float* W, int K, int N, bf16_t* WT, float* scr, int item, int lane) {
    const int nblk = N / 32, kb = item / nblk, nb = item % nblk, k0 = 64 * kb, n0 = 32 * nb;
#pragma unroll 8
    for (int i = 0; i < 32; ++i) { const int kk = 2 * i + (lane >> 5); scr[kk * 33 + (lane & 31)] = W[(size_t)(k0 + kk) * N + n0 + (lane & 31)]; }
    asm volatile("s_waitcnt lgkmcnt(0)" ::: "memory");
    const int c = lane & 7;
#pragma unroll
    for (int j = 0; j < 4; ++j) { const int n = (lane >> 3) + 8 * j; const float* s = scr + (8 * c) * 33 + n;
        u32x4 o; o.x = pk2(s[0 * 33], s[1 * 33]); o.y = pk2(s[2 * 33], s[3 * 33]); o.z = pk2(s[4 * 33], s[5 * 33]); o.w = pk2(s[6 * 33], s[7 * 33]);
        *(u32x4*)(WT + (size_t)(n0 + n) * K + k0 + 8 * c) = o; }
    asm volatile("s_waitcnt lgkmcnt(0)" ::: "memory");
}

DI void phase0(const P& p, unsigned char* shm) {
    const int tid = otid(), lane = tid & 63, wid = tid >> 6;
    unsigned char* ws = p.ws;
    {
        float* scr = (float*)shm + wid * (64 * 33);
        const int gw = blockIdx.x * 8 + wid, NGW = gridDim.x * 8;
        constexpr int I_IN = 16 * 96, I_HO = 16 * 32, I_1 = 16 * 128, I_2 = 64 * 32, I_QKV = 16 * 48, I_AO = 16 * 32;
        constexpr int NITEMS = I_IN + I_HO + 2 * I_1 + 2 * I_2 + I_QKV + I_AO;
        for (int it = gw; it < NITEMS; it += NGW) {
            int r = it;
            if (r < I_IN) { transpose_item(p.hy_w_in, DM, 3 * DM, (bf16_t*)(ws + OFF_WIN), scr, r, lane); continue; } r -= I_IN;
            if (r < I_HO) { transpose_item(p.hy_w_out, DM, DM, (bf16_t*)(ws + OFF_WHO), scr, r, lane); continue; } r -= I_HO;
            if (r < 2 * I_1) { const int l = r / I_1; transpose_item(p.mlp_w1 + (size_t)l * DM * DFF, DM, DFF, (bf16_t*)(ws + OFF_W1) + (size_t)l * DM * DFF, scr, r % I_1, lane); continue; } r -= 2 * I_1;
            if (r < 2 * I_2) { const int l = r / I_2; transpose_item(p.mlp_w2 + (size_t)l * DM * DFF, DFF, DM, (bf16_t*)(ws + OFF_W2) + (size_t)l * DM * DFF, scr, r % I_2, lane); continue; } r -= 2 * I_2;
            if (r < I_QKV) { transpose_item(p.at_w_qkv, DM, 1536, (bf16_t*)(ws + OFF_WQKV), scr, r, lane); continue; } r -= I_QKV;
            transpose_item(p.at_w_out, DM, DM, (bf16_t*)(ws + OFF_WAO), scr, r, lane);
        }
    }
    __syncthreads();
    {
        float* sv = (float*)shm;
        float* part = sv + 9 * 1024;
        float* modv = (float*)(ws + OFF_MOD);
        bool filled = false;
        for (int it = blockIdx.x; it < 2 * 96; it += gridDim.x) {
            if (!filled) {
                for (int i = tid; i < 9 * 1024; i += 512) { const float v = (i < 8192) ? p.c[i] : p.c_ctx[i - 8192]; sv[i] = v / (1.f + __expf(-v)); }
                filled = true;
            }
            __syncthreads();
            const int l = it / 96, n0 = (it % 96) * 64;
            const float* w = p.mod_w + (size_t)l * DM * 6144 + n0 + lane;
            float acc[9];
#pragma unroll
            for (int bb = 0; bb < 9; ++bb) acc[bb] = 0.f;
            const int kb = wid * 128;
#pragma unroll 4
            for (int k = 0; k < 128; ++k) { const float wv = w[(size_t)(kb + k) * 6144];
#pragma unroll
                for (int bb = 0; bb < 9; ++bb) acc[bb] += sv[bb * 1024 + kb + k] * wv; }
#pragma unroll
            for (int bb = 0; bb < 9; ++bb) part[(wid * 9 + bb) * 64 + lane] = acc[bb];
            __syncthreads();
            for (int o = tid; o < 9 * 64; o += 512) { const int bb = o >> 6, n = o & 63; float s = p.mod_b[l * 6144 + n0 + n];
#pragma unroll
                for (int w8 = 0; w8 < 8; ++w8) s += part[(w8 * 9 + bb) * 64 + n];
                modv[(l * 9 + bb) * 6144 + n0 + n] = s; }
        }
    }
    __syncthreads();
    {
        float* zs = (float*)shm;
        float* h1 = zs + 8 * 40;
        const int tl = tid >> 6, j = lane;
        for (int it = blockIdx.x; it < 1024 + 32; it += gridDim.x) {
            const bool cx = it >= 1024; const int Ls = cx ? CL : SEQ; const int pos = (cx ? (it - 1024) : it) * 8 + tl;
            __syncthreads();
            if (j < 33) { float zv;
                if (j == 0) zv = (float)pos / (float)Ls;
                else { const int bi = (j - 1) & 15; const float band = 1e-4f + (float)bi * ((15.f - 1e-4f) / 15.f); const float turns = (float)pos * band / (float)Ls;
                    zv = (j <= 16) ? __builtin_amdgcn_cosf(turns) : -__builtin_amdgcn_sinf(turns); }
                zs[tl * 40 + j] = zv; }
            __syncthreads();
            { float a = p.hy_f_b1[j];
#pragma unroll 3
                for (int i = 0; i < 33; ++i) a += zs[tl * 40 + i] * p.hy_f_w1[i * 64 + j];
                h1[tl * 64 + j] = __sinf(p.hy_f_fr1[j] * a); }
            __syncthreads();
            { float a = p.hy_f_b2[j];
#pragma unroll 4
                for (int k = 0; k < 64; ++k) a += h1[tl * 64 + k] * p.hy_f_w2[k * 64 + j];
                float* H = (float*)(ws + (cx ? OFF_H2C : OFF_H2));
                H[(size_t)pos * 64 + j] = __sinf(p.hy_f_fr2[j] * a); }
        }
    }
    __syncthreads();
}

DI void kcgen_phase(const P& p, unsigned char* shm) {
    const int tid = otid(); const int lane = tid & 63, wid = __builtin_amdgcn_readfirstlane(tid >> 6);
    unsigned char* ws = p.ws;
    float* w3s = (float*)shm;
    const float* __restrict__ w3 = p.hy_f_w3;
    for (int it = blockIdx.x; it < 256; it += gridDim.x) {
        const int cc = it & 15, tg = it >> 4;
        __syncthreads();
        { const int k = tid >> 3, ci8 = (tid & 7) * 8;
#pragma unroll
            for (int dir = 0; dir < 2; ++dir) { const float* src = w3 + (size_t)k * 2048 + dir * 1024 + cc * 64 + ci8;
                const f32x4 v0 = *(const f32x4*)src, v1 = *(const f32x4*)(src + 4);
                float* d = w3s + (dir * 64 + ci8) * 64 + k;
                d[0] = v0.x; d[64] = v0.y; d[128] = v0.z; d[192] = v0.w; d[256] = v1.x; d[320] = v1.y; d[384] = v1.z; d[448] = v1.w; } }
        __syncthreads();
#pragma unroll 1
        for (int part = 0; part < 2; ++part) {
            const bool cx = part == 1; const int Ls = cx ? CL : SEQ;
            if (cx && wid >= 4) break;
            const int t = (cx ? wid : tg * 8 + wid) * 64 + lane;
            const float* H = (const float*)(ws + (cx ? OFF_H2C : OFF_H2)) + (size_t)t * 64;
            float h[64];
#pragma unroll
            for (int k = 0; k < 16; ++k) { const f32x4 v = *(const f32x4*)(H + 4 * k); h[4 * k] = v.x; h[4 * k + 1] = v.y; h[4 * k + 2] = v.z; h[4 * k + 3] = v.w; }
            float* kc = (float*)(ws + (cx ? OFF_KCUC : OFF_KCU));
            float* nrm = (float*)(ws + OFF_NORM) + (cx ? 1024 : 0);
            const float tf = (float)t / (float)Ls;
            const int ci_lo = cx ? 4 * tg : 0, ci_hi = cx ? 4 * tg + 4 : 64;
#pragma unroll 1
            for (int ci = ci_lo; ci < ci_hi; ++ci) {
                const int c = cc * 64 + ci;
                float af = 0.f, ab = 0.f;
#pragma unroll
                for (int k4 = 0; k4 < 16; ++k4) { const f32x4 wf = *(const f32x4*)(w3s + ci * 64 + 4 * k4), wb = *(const f32x4*)(w3s + (64 + ci) * 64 + 4 * k4);
                    af += h[4 * k4] * wf.x; af += h[4 * k4 + 1] * wf.y; af += h[4 * k4 + 2] * wf.z; af += h[4 * k4 + 3] * wf.w;
                    ab += h[4 * k4] * wb.x; ab += h[4 * k4 + 1] * wb.y; ab += h[4 * k4 + 2] * wb.z; ab += h[4 * k4 + 3] * wb.w; }
                const float delta = fabsf(-3.0701134573253945f + (float)c * ((-15.350567286626973f + 3.0701134573253945f) / 1023.f));
                const float dec = __expf(-tf * delta);
                const float vf = af * dec, vb = ab * dec;
                float* row = kc + (size_t)c * (2 * Ls);
                row[t] = vf;
                if (t >= 1) row[2 * Ls - t] = vb; else row[Ls] = 0.f;
                float sabs = fabsf(vf) + (t >= 1 ? fabsf(vb) : 0.f);
                sabs = wave_sum(sabs);
                if (lane == 0) atomicAdd(nrm + c, sabs);
            }
        }
    }
    __syncthreads();
}

DI void sw_phase(const P& p, unsigned char* shm) {
    const int tid = otid(), lane = tid & 63, wid = tid >> 6;
    unsigned char* ws = p.ws;
    float* sv = (float*)shm;
    float* part = sv + 9 * 1024;
    const float* modv = (const float*)(ws + OFF_MOD);
    for (int it = blockIdx.x; it < 64 + 24 + 64; it += gridDim.x) {
        int j, n0, ldw; const float* W; const float* shv;
        if (it < 64) { j = 0; n0 = it * 64; ldw = DFF; W = p.mlp_w1; shv = modv + 3 * 1024; }
        else if (it < 88) { j = 1; n0 = (it - 64) * 64; ldw = 1536; W = p.at_w_qkv; shv = modv + 9 * 6144; }
        else { j = 2; n0 = (it - 88) * 64; ldw = DFF; W = p.mlp_w1 + (size_t)DM * DFF; shv = modv + 9 * 6144 + 3 * 1024; }
        __syncthreads();
        for (int i = tid; i < 9 * 1024; i += 512) sv[i] = shv[(i >> 10) * 6144 + (i & 1023)];
        __syncthreads();
        const float* w = W + n0 + lane;
        float acc[9];
#pragma unroll
        for (int bb = 0; bb < 9; ++bb) acc[bb] = 0.f;
        const int kb = wid * 128;
#pragma unroll 4
        for (int k = 0; k < 128; ++k) { const float wv = w[(size_t)(kb + k) * ldw];
#pragma unroll
            for (int bb = 0; bb < 9; ++bb) acc[bb] += sv[bb * 1024 + kb + k] * wv; }
#pragma unroll
        for (int bb = 0; bb < 9; ++bb) part[(wid * 9 + bb) * 64 + lane] = acc[bb];
        __syncthreads();
        float* sw = (float*)(ws + OFF_SW) + j * 9 * 4096;
        for (int o = tid; o < 9 * 64; o += 512) { const int bb = o >> 6, n = o & 63; float a = 0.f;
#pragma unroll
            for (int w8 = 0; w8 < 8; ++w8) a += part[(w8 * 9 + bb) * 64 + n];
            sw[bb * 4096 + n0 + n] = a; }
    }
    __syncthreads();
}

DI void rnorm_phase(const float* part, float* r, int nrows) {
    const int tid = otid();
    for (int row = blockIdx.x * 512 + tid; row < nrows; row += gridDim.x * 512) {
        const f32x4* q = (const f32x4*)(part + (size_t)row * 16);
        const f32x4 a = q[0], b = q[1], c = q[2], d = q[3];
        const float ssum = ((a.x + a.y) + (a.z + a.w)) + ((b.x + b.y) + (b.z + b.w)) + ((c.x + c.y) + (c.z + c.w)) + ((d.x + d.y) + (d.z + d.w));
        r[row] = __builtin_amdgcn_rsqf(ssum * (1.f / DM) + EPS);
    }
}

DI void ctx_finalize(const float* part, int ksplit, const float* srcf  , const float* bias, bf16_t* cxb, const float* gate8, const float* gw, const float* scl8, bf16_t* xgc, float* rc) {
    const int tid = otid(); const int lane = tid & 63, wid = tid >> 6;
    for (int row = blockIdx.x * 8 + wid; row < TC; row += gridDim.x * 8) {
        f32x4 a[4];
#pragma unroll
        for (int j = 0; j < 4; ++j) a[j] = (f32x4){0.f, 0.f, 0.f, 0.f};
        for (int ks = 0; ks < ksplit; ++ks) { const float* pr = part + ((size_t)ks * TC + row) * DM + 4 * lane;
#pragma unroll
            for (int j = 0; j < 4; ++j) a[j] += *(const f32x4*)(pr + 256 * j); }
        float ss = 0.f; f32x4 o[4];
#pragma unroll
        for (int j = 0; j < 4; ++j) { const int c = 4 * lane + 256 * j; f32x4 sv;
            if (srcf) sv = *(const f32x4*)(srcf + (size_t)row * DM + c);
            else { const u32x2 w = *(const u32x2*)(cxb + (size_t)row * DM + c); sv = (f32x4){bf_lo(w.x), bf_hi(w.x), bf_lo(w.y), bf_hi(w.y)}; }
            if (bias) a[j] += *(const f32x4*)(bias + c);
            o[j] = sv + *(const f32x4*)(gate8 + c) * a[j];
            ss += (o[j].x * o[j].x + o[j].y * o[j].y) + (o[j].z * o[j].z + o[j].w * o[j].w); }
        ss = wave_sum(ss);
        if (lane == 0) rc[row] = __builtin_amdgcn_rsqf(ss * (1.f / DM) + EPS);
#pragma unroll
        for (int j = 0; j < 4; ++j) { const int c = 4 * lane + 256 * j;
            u32x2 w; w.x = pk2(o[j].x, o[j].y); w.y = pk2(o[j].z, o[j].w); *(u32x2*)(cxb + (size_t)row * DM + c) = w;
            const f32x4 t = o[j] * (*(const f32x4*)(gw + c)) * (*(const f32x4*)(scl8 + c) + 1.f);
            u32x2 x; x.x = pk2(t.x, t.y); x.y = pk2(t.z, t.w); *(u32x2*)(xgc + (size_t)row * DM + c) = x; }
    }
}

DI void norm_phase(const float* srcX, const float* srcC, const float* g, const float* modl  , int shift_chunk, int scale_chunk, bf16_t* hbuf, int nrows) {
    const int tid = otid(); const int lane = tid & 63, wid = tid >> 6;
    const int gw = blockIdx.x * 8 + wid, NGW = gridDim.x * 8;
    f32x4 gv[4];
#pragma unroll
    for (int j = 0; j < 4; ++j) gv[j] = *(const f32x4*)(g + 4 * lane + 256 * j);
    for (int row0 = gw; row0 < nrows; row0 += 2 * NGW) {
        f32x4 v[2][4];
#pragma unroll
        for (int rr = 0; rr < 2; ++rr) { const int row = row0 + rr * NGW; const bool lat = row < TX;
            const float* xr = lat ? srcX + (size_t)row * DM : srcC + (size_t)(row - TX) * DM;
#pragma unroll
            for (int j = 0; j < 4; ++j) v[rr][j] = (row < nrows) ? *(const f32x4*)(xr + 4 * lane + 256 * j) : (f32x4){0.f, 0.f, 0.f, 0.f}; }
#pragma unroll
        for (int rr = 0; rr < 2; ++rr) { const int row = row0 + rr * NGW; const bool lat = row < TX; const int mi = lat ? (row >> 13) : 8;
            float ss = 0.f;
#pragma unroll
            for (int j = 0; j < 4; ++j) ss += (v[rr][j].x * v[rr][j].x + v[rr][j].y * v[rr][j].y) + (v[rr][j].z * v[rr][j].z + v[rr][j].w * v[rr][j].w);
            ss = wave_sum(ss);
            const float r = __builtin_amdgcn_rsqf(ss * (1.f / DM) + EPS);
            const float* sh = modl + mi * 6144 + shift_chunk * 1024; const float* sc = modl + mi * 6144 + scale_chunk * 1024;
            if (row < nrows) { bf16_t* orow = hbuf + (size_t)row * DM;
#pragma unroll
                for (int j = 0; j < 4; ++j) { const f32x4 s4 = *(const f32x4*)(sh + 4 * lane + 256 * j), c1 = *(const f32x4*)(sc + 4 * lane + 256 * j);
                    const f32x4 y = v[rr][j] * r * gv[j] * (c1 + 1.f) + s4;
                    u32x2 w; w.x = pk2(y.x, y.y); w.y = pk2(y.z, y.w);
                    *(u32x2*)(orow + 4 * lane + 256 * j) = w; } }
        }
    }
}

DI void conv_item_coords(int item, int& b, int& tt, int& ct, int& rowb, int& Ls) {
    if (item < 16384) { ct = item & 15; tt = (item >> 4) & 127; b = item >> 11; rowb = b * SEQ; Ls = SEQ; }
    else { const int j = item - 16384; ct = j & 15; tt = (j >> 4) & 3; b = j >> 6; rowb = TX + b * CL; Ls = CL; }
}
DI void conv8(const bf16_t* seq, int t0, int Ls, float w0, float w1, float w2, float cb, float (&o)[8]) {
    float xm[8]; unpack8(*(const u32x4*)(seq + t0), xm);
    const float xl = (t0 > 0) ? bf1(seq[t0 - 1]) : 0.f, xr = (t0 + 8 < Ls) ? bf1(seq[t0 + 8]) : 0.f;
    o[0] = cb + w0 * xl + w1 * xm[0] + w2 * xm[1];
#pragma unroll
    for (int e = 1; e < 7; ++e) o[e] = cb + w0 * xm[e - 1] + w1 * xm[e] + w2 * xm[e + 1];
    o[7] = cb + w0 * xm[6] + w1 * xm[7] + w2 * xr;
}
struct ZIn { u32x4 x, y; float xl, xr, w0, w1, w2, cb; };
DI void zback_load(const P& p, int item, int tid, ZIn& z) {
    int b, tt, ct, rowb, Ls; conv_item_coords(item, b, tt, ct, rowb, Ls);
    const int cl = tid >> 3, t8 = (tid & 7) * 8, c = ct * 64 + cl, t0 = tt * 64 + t8;
    const bf16_t* seq = (const bf16_t*)(p.ws + OFF_BIG) + (size_t)c * TT + rowb;
    z.x = *(const u32x4*)(seq + t0);
    z.xl = (t0 > 0) ? bf1(seq[t0 - 1]) : 0.f; z.xr = (t0 + 8 < Ls) ? bf1(seq[t0 + 8]) : 0.f;
    z.y = *(const u32x4*)((Ls == SEQ) ? (const bf16_t*)(p.ws + OFF_UT) + ((size_t)(b * DM + c)) * SEQ + t0 : (const bf16_t*)(p.ws + OFF_UTC) + ((size_t)(b * DM + c)) * CL + t0);
    z.w0 = p.hy_conv_w[c]; z.w1 = p.hy_conv_w[3072 + c]; z.w2 = p.hy_conv_w[6144 + c]; z.cb = p.hy_conv_b[c];
}
DI void zback_phase(const P& p, unsigned char* shm) {
    const int tid = otid();
    bf16_t* hbuf = (bf16_t*)(p.ws + OFF_HBUF);
    bf16_t* zs = (bf16_t*)shm;
    constexpr int NIT = 16384 + 512;
    ZIn cur, nxt, nx2;
    int item = blockIdx.x;
    if (item < NIT) zback_load(p, item, tid, cur);
    if (item + (int)gridDim.x < NIT) zback_load(p, item + gridDim.x, tid, nxt); else nxt = cur;
    for (; item < NIT; item += gridDim.x) {
        const int nitem = item + 2 * gridDim.x;
        if (nitem < NIT) zback_load(p, nitem, tid, nx2); else nx2 = nxt;
        int b, tt, ct, rowb, Ls; conv_item_coords(item, b, tt, ct, rowb, Ls);
        { const int cl = tid >> 3, t8 = (tid & 7) * 8;
            float xm[8], yv[8], o[8]; unpack8(cur.x, xm); unpack8(cur.y, yv);
            o[0] = cur.cb + cur.w0 * cur.xl + cur.w1 * xm[0] + cur.w2 * xm[1];
#pragma unroll
            for (int e = 1; e < 7; ++e) o[e] = cur.cb + cur.w0 * xm[e - 1] + cur.w1 * xm[e] + cur.w2 * xm[e + 1];
            o[7] = cur.cb + cur.w0 * xm[6] + cur.w1 * xm[7] + cur.w2 * cur.xr;
#pragma unroll
            for (int e = 0; e < 8; ++e) o[e] *= yv[e];
            __syncthreads();
            *(u32x4*)(zs + cl * 72 + t8) = pack8(o); }
        __syncthreads();
        { const int tl = tid >> 3, c8 = (tid & 7) * 8;
            float z[8];
#pragma unroll
            for (int e = 0; e < 8; ++e) z[e] = bf1(zs[(c8 + e) * 72 + tl]);
            *(u32x4*)(hbuf + (size_t)(rowb + tt * 64 + tl) * DM + ct * 64 + c8) = pack8(z); }
        cur = nxt; nxt = nx2;
    }
    __syncthreads();
}

constexpr float C16[8] = {1.f, 0.92387953251128674f, 0.70710678118654752f, 0.38268343236508977f, 0.f, -0.38268343236508977f, -0.70710678118654752f, -0.92387953251128674f};
constexpr float S16[8] = {0.f, 0.38268343236508977f, 0.70710678118654752f, 0.92387953251128674f, 1.f, 0.92387953251128674f, 0.70710678118654752f, 0.38268343236508977f};
DI f2_t cmul(f2_t a, f2_t w) { return (f2_t){a.x, a.x} * w + (f2_t){a.y, a.y} * (f2_t){-w.y, w.x}; }
DI f2_t cmulc(f2_t a, f2_t w) { return (f2_t){a.x, a.x} * (f2_t){w.x, -w.y} + (f2_t){a.y, a.y} * (f2_t){w.y, w.x}; }
DI f2_t mul_mi(f2_t a) { return (f2_t){a.y, -a.x}; }
DI f2_t mul_pi(f2_t a) { return (f2_t){-a.y, a.x}; }
template <int R, int LEN, bool INV> DI void dif_stages(f2_t (&x)[R]) {
    constexpr int half = LEN / 2, ts = 16 / LEN;
#pragma unroll
    for (int blk = 0; blk < R; blk += LEN)
#pragma unroll
        for (int j = 0; j < half; ++j) {
            const int i0 = blk + j, i1 = i0 + half;
            const f2_t a = x[i0], b = x[i1];
            x[i0] = a + b;
            const f2_t t = a - b;
            const int k = j * ts;
            if (k == 0) x[i1] = t;
            else if (k == 4) x[i1] = INV ? mul_pi(t) : mul_mi(t);
            else { const f2_t w = {C16[k], S16[k]}; x[i1] = INV ? cmul(t, w) : cmulc(t, w); }
        }
    if constexpr (LEN > 2) dif_stages<R, LEN / 2, INV>(x);
}
template <int R> DI constexpr int brev(int p) { int r = 0; for (int i = 0, b = (R == 8 ? 3 : 4); i < b; ++i) r |= ((p >> i) & 1) << (b - 1 - i); return r; }

template <int PASS, bool INV> DI void bfly_addr(int q, int& a0, int& astr, int& np) {
    if (PASS == 1) { a0 = (q >> 7) * 129 + (q & 127); astr = 16 * 129; np = q; }
    else if (PASS == 2) { a0 = (q >> 7) * 16 * 129 + (q & 127); astr = 129; np = q & 127; }
    else if (PASS == 3) { a0 = (q & 127) * 129 + (q >> 7); astr = 16; np = q >> 7; }
    else { a0 = (q & 127) * 129 + (q >> 7) * 16; astr = 1; np = 0; }
    if (PASS != 4) asm volatile("" : "+v"(np));
}
template <int R> DI void tw_powers(f2_t w1, f2_t (&pw)[R]) {
    pw[1] = w1;
#pragma unroll
    for (int k = 2; k < R; ++k) { const int hb = (k >= 8) ? 8 : (k >= 4) ? 4 : 2; const int lo = k - hb;
        if (lo == 0) pw[k] = cmul(pw[hb / 2], pw[hb / 2]); else pw[k] = cmul(pw[hb], pw[lo]); }
}
template <int PASS, bool INV, int MODE, int R> DI void bfly_compute(f2_t (&x)[R], int np) {
    constexpr float invM = (PASS == 1) ? (1.f / 16384.f) : (PASS == 2) ? (1.f / 2048.f) : (1.f / 128.f);
    f2_t pw[R];
    if (PASS != 4) { const float turns = (float)np * invM; f2_t w1 = {__builtin_amdgcn_cosf(turns), __builtin_amdgcn_sinf(turns)}; if (!INV) w1.y = -w1.y; tw_powers<R>(w1, pw); }
    if (INV && PASS != 4) {
#pragma unroll
        for (int k = 1; k < R; ++k) x[k] = cmul(x[k], pw[k]);
    }
    if (MODE == 1) {
        x[4] = x[0]; x[5] = cmulc(x[1], (f2_t){S16[2], S16[2]}); x[6] = mul_mi(x[2]); x[7] = cmulc(x[3], (f2_t){-S16[2], S16[2]});
        dif_stages<R, 4, INV>(x);
    } else dif_stages<R, R, INV>(x);
    if (!INV && PASS != 4) {
#pragma unroll
        for (int k = 1; k < R; ++k) { const int pp = brev<R>(k); x[pp] = cmul(x[pp], pw[k]); }
    }
}
template <int PASS, bool INV, int MODE> DI void fft_pass(f2_t* lds, int tid, const f2_t* kmul, f2_t* kout, float sc) {
    constexpr int R = (PASS == 1 || PASS == 3) ? 8 : 16;
    constexpr int NBF = 16384 / R;
    constexpr int RL = (MODE == 1) ? R / 2 : R;
#pragma unroll 1
    for (int q = tid; q < NBF; q += 1024) {
        int a0A, asA, npA, a0B, asB, npB;
        bfly_addr<PASS, INV>(q, a0A, asA, npA); bfly_addr<PASS, INV>(q + 512, a0B, asB, npB);
        f2_t xA[R], xB[R];
#pragma unroll
        for (int n = 0; n < RL; ++n) { xA[n] = lds[a0A + n * asA]; xB[n] = lds[a0B + n * asB]; }
        bfly_compute<PASS, INV, MODE, R>(xA, npA);
        bfly_compute<PASS, INV, MODE, R>(xB, npB);
#pragma unroll
        for (int pp = 0; pp < R; ++pp) {
            if (MODE == 4 && (pp & 1)) continue;
            const int aA = a0A + brev<R>(pp) * asA, aB = a0B + brev<R>(pp) * asB;
            f2_t v = xA[pp], w = xB[pp];
            if (MODE == 2) { v = cmul(v, kmul[aA]); w = cmul(w, kmul[aB]); }
            if (MODE == 3) { v = v * sc; w = w * sc; kout[aA] = v; kout[aB] = w; }
            else { lds[aA] = v; lds[aB] = w; }
        }
    }
    __syncthreads();
}

DI void fftconv_phase(const P& p, unsigned char* shm) {
    const int tid = otid(), lane = tid & 63, wid = tid >> 6;
    if (__builtin_amdgcn_readfirstlane(tid) >= 256) __builtin_amdgcn_s_setprio(1);
    unsigned char* ws = p.ws;
    f2_t* lds = (f2_t*)shm;
    f2_t* kscr2 = (f2_t*)(ws + OFF_HBUF) + (size_t)blockIdx.x * (2 * 16512);
    const float* nrm = (const float*)(ws + OFF_NORM);
    for (int cpair = blockIdx.x; cpair < DM; cpair += 2 * gridDim.x)
    for (int which = 0; which < 2; ++which) {
        const int c = cpair + which * gridDim.x;
        if (c >= DM) break;
        f2_t* kscr = kscr2 + which * 16512;
        if (which == 0) {
            const int cB = cpair + gridDim.x; const bool hasB = cB < DM;
            __syncthreads();
            { const float* kcA = (const float*)(ws + OFF_KCU) + (size_t)cpair * 16384; const float* kcB = (const float*)(ws + OFF_KCU) + (size_t)(hasB ? cB : cpair) * 16384;
#pragma unroll 4
                for (int i = tid * 4; i < 16384; i += 2048) { const f32x4 v = *(const f32x4*)(kcA + i); f32x4 w = *(const f32x4*)(kcB + i); if (!hasB) w = (f32x4){0.f, 0.f, 0.f, 0.f};
                    const int a = (i >> 7) * 129 + (i & 127);
                    lds[a] = (f2_t){v.x, w.x}; lds[a + 1] = (f2_t){v.y, w.y}; lds[a + 2] = (f2_t){v.z, w.z}; lds[a + 3] = (f2_t){v.w, w.w}; } }
            __syncthreads();
            fft_pass<1, false, 0>(lds, tid, nullptr, nullptr, 0.f); fft_pass<2, false, 0>(lds, tid, nullptr, nullptr, 0.f); fft_pass<3, false, 0>(lds, tid, nullptr, nullptr, 0.f);
            fft_pass<4, false, 0>(lds, tid, nullptr, nullptr, 0.f);
            { const float sA = 0.5f / (16384.f * nrm[cpair]), sB = 0.5f / (16384.f * nrm[hasB ? cB : cpair]);
#pragma unroll 4
                for (int pq = tid; pq < 16384; pq += 512) {
                    const int k = (pq >> 11) + (((pq >> 7) & 15) << 3) + (((pq >> 4) & 7) << 7) + ((pq & 15) << 10);
                    const int kn = (16384 - k) & 16383;
                    const int pn = ((kn & 7) << 11) + (((kn >> 3) & 15) << 7) + (((kn >> 7) & 7) << 4) + (kn >> 10);
                    const int a = (pq >> 7) * 129 + (pq & 127), an = (pn >> 7) * 129 + (pn & 127);
                    const f2_t z = lds[a], zn = lds[an];
                    kscr2[a] = (f2_t){(z.x + zn.x) * sA, (z.y - zn.y) * sA};
                    kscr2[16512 + a] = (f2_t){(z.y + zn.y) * sB, (zn.x - z.x) * sB}; } }
        }
        const float skip = p.hy_skip[c];
        const bf16_t* x1r = (const bf16_t*)(ws + OFF_BIG) + (size_t)(DM + c) * TT; const bf16_t* vr = (const bf16_t*)(ws + OFF_BIG) + (size_t)(2 * DM + c) * TT;
        const float wx0 = p.hy_conv_w[DM + c], wx1 = p.hy_conv_w[3072 + DM + c], wx2 = p.hy_conv_w[6144 + DM + c], cbx = p.hy_conv_b[DM + c];
        const float wv0 = p.hy_conv_w[2 * DM + c], wv1 = p.hy_conv_w[3072 + 2 * DM + c], wv2 = p.hy_conv_w[6144 + 2 * DM + c], cbv = p.hy_conv_b[2 * DM + c];
#pragma unroll 1
        for (int bp = 0; bp < 4; ++bp) {
            bf16_t* u0 = (bf16_t*)(ws + OFF_UT) + ((size_t)((2 * bp) * DM + c)) * SEQ;
            bf16_t* u1 = u0 + (size_t)DM * SEQ;
            const bf16_t* sx = x1r + (2 * bp) * SEQ; const bf16_t* sv = vr + (2 * bp) * SEQ;
            __syncthreads();
#pragma unroll
            for (int jj = 0; jj < 2; ++jj) { const int t0 = (tid + 512 * jj) * 8;
                float a[8], b[8], a2[8], b2[8];
                conv8(sx, t0, SEQ, wx0, wx1, wx2, cbx, a); conv8(sv, t0, SEQ, wv0, wv1, wv2, cbv, a2);
                conv8(sx + SEQ, t0, SEQ, wx0, wx1, wx2, cbx, b); conv8(sv + SEQ, t0, SEQ, wv0, wv1, wv2, cbv, b2);
                const int ad = (t0 >> 7) * 129 + (t0 & 127);
#pragma unroll
                for (int e = 0; e < 8; ++e) lds[ad + e] = (f2_t){a[e] * a2[e], b[e] * b2[e]}; }
            __syncthreads();
            fft_pass<1, false, 1>(lds, tid, nullptr, nullptr, 0.f); fft_pass<2, false, 0>(lds, tid, nullptr, nullptr, 0.f); fft_pass<3, false, 0>(lds, tid, nullptr, nullptr, 0.f);
            fft_pass<4, false, 2>(lds, tid, kscr, nullptr, 0.f);
            fft_pass<4, true, 0>(lds, tid, nullptr, nullptr, 0.f); fft_pass<3, true, 0>(lds, tid, nullptr, nullptr, 0.f); fft_pass<2, true, 0>(lds, tid, nullptr, nullptr, 0.f);
            fft_pass<1, true, 4>(lds, tid, nullptr, nullptr, 0.f);
#pragma unroll
            for (int jj = 0; jj < 2; ++jj) { const int t0 = (tid + 512 * jj) * 8;
                float a[8], b[8], a2[8], b2[8];
                conv8(sx, t0, SEQ, wx0, wx1, wx2, cbx, a); conv8(sv, t0, SEQ, wv0, wv1, wv2, cbv, a2);
                conv8(sx + SEQ, t0, SEQ, wx0, wx1, wx2, cbx, b); conv8(sv + SEQ, t0, SEQ, wv0, wv1, wv2, cbv, b2);
                const int ad = (t0 >> 7) * 129 + (t0 & 127);
#pragma unroll
                for (int e = 0; e < 8; ++e) { const f2_t v = lds[ad + e]; a[e] = v.x + a[e] * a2[e] * skip; b[e] = v.y + b[e] * b2[e] * skip; }
                *(u32x4*)(u0 + t0) = pack8(a); *(u32x4*)(u1 + t0) = pack8(b); }
        }
        __syncthreads();
        {
            float* kcs = (float*)shm; float* usm = kcs + 512;
            const float* kcc = (const float*)(ws + OFF_KCUC) + (size_t)c * 512;
            const float inrm = 1.f / nrm[1024 + c];
            for (int i = tid; i < 512; i += 512) kcs[i] = kcc[i] * inrm;
            bf16_t* utc = (bf16_t*)(ws + OFF_UTC);
#pragma unroll
            for (int i = tid; i < 2048; i += 512) { const int b = i >> 8, t = i & 255; const bf16_t* qx = x1r + TX + b * CL; const bf16_t* qv = vr + TX + b * CL;
                const float xl = t > 0 ? bf1(qx[t - 1]) : 0.f, xr = t < CL - 1 ? bf1(qx[t + 1]) : 0.f, vl = t > 0 ? bf1(qv[t - 1]) : 0.f, vrr = t < CL - 1 ? bf1(qv[t + 1]) : 0.f;
                usm[i] = (cbx + wx0 * xl + wx1 * bf1(qx[t]) + wx2 * xr) * (cbv + wv0 * vl + wv1 * bf1(qv[t]) + wv2 * vrr); }
            __syncthreads();
            const int b = wid;
            float acc[4] = {0.f, 0.f, 0.f, 0.f};
            float ur[4];
#pragma unroll
            for (int k = 0; k < 4; ++k) ur[k] = usm[b * 256 + 64 * k + lane];
#pragma unroll 4
            for (int sl = 0; sl < 64; ++sl) {
                float kv[7];
#pragma unroll
                for (int d = 0; d < 7; ++d) kv[d] = kcs[(lane - sl + 64 * (d - 3)) & 511];
                float uk[4];
#pragma unroll
                for (int k = 0; k < 4; ++k) uk[k] = __builtin_bit_cast(float, __builtin_amdgcn_readlane(__builtin_bit_cast(int, ur[k]), sl));
#pragma unroll
                for (int jj = 0; jj < 4; ++jj)
#pragma unroll
                    for (int k = 0; k < 4; ++k) acc[jj] += uk[k] * kv[jj - k + 3];
            }
#pragma unroll
            for (int jj = 0; jj < 4; ++jj) { const int t = lane + 64 * jj; utc[((size_t)(b * DM + c)) * CL + t] = f2bf(acc[jj] + usm[b * 256 + t] * skip); }
        }
    }
    __builtin_amdgcn_s_setprio(0);
    __syncthreads();
}

DI void kprep_phase(const P& p) {
    const int tid = otid(); const int lane = tid & 63, wid = tid >> 6;
    const int gw = blockIdx.x * 8 + wid, NGW = gridDim.x * 8;
    bf16_t* qkv = (bf16_t*)(p.ws + OFF_BIG);
    const int j = lane & 7, hk = (lane >> 3) & 3, rsel = lane >> 5;
    float kn[8], inv[8];
#pragma unroll
    for (int e = 0; e < 8; ++e) { kn[e] = p.at_k_norm[8 * j + e];
        inv[e] = __builtin_amdgcn_exp2f(-(float)(8 * (j & 1) + e) * (13.287712379549449f / 16.f)) * 0.15915494309189535f; }
    const bool rowax = j < 4, hi = (j & 2) != 0;
    for (int it0 = gw; 2 * it0 < TT; it0 += 2 * NGW) {
        u32x4 w[2];
#pragma unroll
        for (int rr = 0; rr < 2; ++rr) { const int row = 2 * (it0 + rr * NGW) + rsel;
            w[rr] = (row < TT) ? *(const u32x4*)(qkv + (size_t)row * 1536 + 1024 + hk * 64 + 8 * j) : (u32x4){0u, 0u, 0u, 0u}; }
#pragma unroll
        for (int rr = 0; rr < 2; ++rr) { const int row = 2 * (it0 + rr * NGW) + rsel; const bool lat = row < TX;
            float x[8]; unpack8(w[rr], x);
            float ss = 0.f;
#pragma unroll
            for (int e = 0; e < 8; ++e) ss += x[e] * x[e];
            ss += dpp_mov<0xB1>(ss); ss += dpp_mov<0x4E>(ss); ss += dpp_mov<0x141>(ss);
            const float rs = __builtin_amdgcn_rsqf(ss * (1.f / 64.f) + EPS);
            const int t = row & (SEQ - 1); const float pos = (float)(rowax ? (t >> 6) : (t & 63));
#pragma unroll
            for (int e = 0; e < 8; ++e) { float y = x[e] * rs * kn[e];
                const float pr = dpp_mov<0x4E>(y);
                const float turns = pos * inv[e]; const float cs = __builtin_amdgcn_cosf(turns), sn = __builtin_amdgcn_sinf(turns);
                if (lat) y = hi ? (y * cs + pr * sn) : (y * cs - pr * sn);
                x[e] = y; }
            if (row < TT) *(u32x4*)(qkv + (size_t)row * 1536 + 1024 + hk * 64 + 8 * j) = pack8(x); }
    }
}

DI void attn_stage_load(const bf16_t* qkv, int rowk, int g, int tid, u32x4 (&kr)[2], u32x4 (&vr)[2]) {
    { const int key = tid >> 2, c4 = tid & 3; const bf16_t* src = qkv + (size_t)(rowk + key) * 1536 + 1024 + g * 64 + c4 * 16; kr[0] = *(const u32x4*)src; kr[1] = *(const u32x4*)(src + 8); }
    { const int key = tid & 127, dg = tid >> 7; const bf16_t* src = qkv + (size_t)(rowk + key) * 1536 + 1280 + g * 64 + dg * 8; vr[0] = *(const u32x4*)src; vr[1] = *(const u32x4*)(src + 32); }
}
DI void attn_stage_store(bf16_t* Ks, bf16_t* Vt, int tid, const u32x4 (&kr)[2], const u32x4 (&vr)[2]) {
    { const int key = tid >> 2, c4 = tid & 3; *(u32x4*)(Ks + key * 72 + c4 * 16) = kr[0]; *(u32x4*)(Ks + key * 72 + c4 * 16 + 8) = kr[1]; }
    { const int key = tid & 127, dg = tid >> 7;
#pragma unroll
        for (int hf = 0; hf < 2; ++hf) { const int d0 = hf * 32 + dg * 8; const u32x4 w = vr[hf];
            Vt[(d0 + 0) * 132 + key] = (bf16_t)(w.x & 0xffff); Vt[(d0 + 1) * 132 + key] = (bf16_t)(w.x >> 16);
            Vt[(d0 + 2) * 132 + key] = (bf16_t)(w.y & 0xffff); Vt[(d0 + 3) * 132 + key] = (bf16_t)(w.y >> 16);
            Vt[(d0 + 4) * 132 + key] = (bf16_t)(w.z & 0xffff); Vt[(d0 + 5) * 132 + key] = (bf16_t)(w.z >> 16);
            Vt[(d0 + 6) * 132 + key] = (bf16_t)(w.w & 0xffff); Vt[(d0 + 7) * 132 + key] = (bf16_t)(w.w >> 16); } }
}
DI void attn_phase(const P& p, unsigned char* shm) {
    const int tid = otid(), lane = tid & 63, wid = tid >> 6, r = lane & 31, h = lane >> 5;
    constexpr int BUFB = 18432 + 16896;
    const bf16_t* qkv = (const bf16_t*)(p.ws + OFF_BIG);
    bf16_t* obuf = (bf16_t*)(p.ws + OFF_HBUF);
    float mq = fabsf(p.at_q_norm[lane]), mk = fabsf(p.at_k_norm[lane]);
#pragma unroll
    for (int o = 1; o < 64; o <<= 1) { mq = fmaxf(mq, __shfl_xor(mq, o)); mk = fmaxf(mk, __shfl_xor(mk, o)); }
    const float negB = -(8.f * LOG2E) * mq * mk;
    for (int unit = blockIdx.x; unit < 2048; unit += gridDim.x) {
        const int qb = unit & 63, g = (unit >> 6) & 3, b = unit >> 8;
        const int q0 = qb * 128, hd = g * 4 + (wid >> 1), woff = (wid & 1) * 64, qs = q0 + woff;
        bf16x8 qf[2][4];
        int hq = h; asm volatile("" : "+v"(hq));
#pragma unroll
        for (int m = 0; m < 2; ++m) {
            const int t = qs + 32 * m + r;
            float x[4][8]; float ss = 0.f;
#pragma unroll
            for (int s = 0; s < 4; ++s) { unpack8(*(const u32x4*)(qkv + (size_t)(b * SEQ + t) * 1536 + hd * 64 + 16 * s + 8 * h), x[s]);
#pragma unroll
                for (int e = 0; e < 8; ++e) ss += x[s][e] * x[s][e]; }
            ss += __shfl_xor(ss, 32);
            const float rs = __builtin_amdgcn_rsqf(ss * (1.f / 64.f) + EPS);
            const float rsq = rs * (0.125f * LOG2E);
#pragma unroll
            for (int s = 0; s < 4; ++s) { const f32x4 g0 = *(const f32x4*)(p.at_q_norm + 16 * s + 8 * hq), g1 = *(const f32x4*)(p.at_q_norm + 16 * s + 8 * hq + 4);
                x[s][0] *= rsq * g0.x; x[s][1] *= rsq * g0.y; x[s][2] *= rsq * g0.z; x[s][3] *= rsq * g0.w; x[s][4] *= rsq * g1.x; x[s][5] *= rsq * g1.y; x[s][6] *= rsq * g1.z; x[s][7] *= rsq * g1.w; }
#pragma unroll
            for (int ax = 0; ax < 2; ++ax) { const float pos = (float)(ax == 0 ? (t >> 6) : (t & 63));
#pragma unroll
                for (int e = 0; e < 8; ++e) { const float turns = pos * (__builtin_amdgcn_exp2f(-(float)(8 * hq + e) * (13.287712379549449f / 16.f)) * 0.15915494309189535f); const float cs = __builtin_amdgcn_cosf(turns), sn = __builtin_amdgcn_sinf(turns);
                    const float x1 = x[2 * ax][e], x2 = x[2 * ax + 1][e];
                    x[2 * ax][e] = x1 * cs - x2 * sn; x[2 * ax + 1][e] = x2 * cs + x1 * sn; } }
#pragma unroll
            for (int s = 0; s < 4; ++s) qf[m][s] = __builtin_bit_cast(bf16x8, pack8(x[s]));
        }
        f32x16 o[2][2];
#pragma unroll
        for (int m = 0; m < 2; ++m)
#pragma unroll
            for (int d = 0; d < 2; ++d)
#pragma unroll
                for (int i = 0; i < 16; ++i) o[m][d][i] = 0.f;
        float lrun[2] = {0.f, 0.f};
        const int ch0 = (q0 == 0) ? 1 : 0;
        auto chunk_row = [&](int ch) { return (ch < 3) ? (b * SEQ + q0 - 128 + 128 * ch) : (TX + b * CL + (ch - 3) * 128); };
        auto chunk_next = [&](int ch) { int n = ch + 1; if (n == 2 && q0 + 128 >= SEQ) n = 3; return n; };
        u32x4 kr[2], vr[2];
        __syncthreads();
        attn_stage_load(qkv, chunk_row(ch0), g, tid, kr, vr);
        attn_stage_store((bf16_t*)shm, (bf16_t*)(shm + 18432), tid, kr, vr);
        __syncthreads();
        int buf = 0;
        for (int ch = ch0; ch < 5; ) {
            const int nch = chunk_next(ch);
            if (nch < 5) attn_stage_load(qkv, chunk_row(nch), g, tid, kr, vr);
            const bf16_t* Ks = (const bf16_t*)(shm + buf * BUFB); const bf16_t* Vt = (const bf16_t*)(shm + buf * BUFB + 18432);
#pragma unroll
            for (int m = 0; m < 2; ++m) {
                const int dk = (woff + 32 * m) >> 5;
                const int kt_lo = (ch == 0) ? dk : 0, kt_hi = (ch == 2) ? dk : 3;
                for (int kt = kt_lo; kt <= kt_hi; ++kt) {
                    f32x16 sa;
#pragma unroll
                    for (int i = 0; i < 16; ++i) sa[i] = negB;
#pragma unroll
                    for (int s = 0; s < 4; ++s) { const bf16x8 a = *(const bf16x8*)(Ks + (kt * 32 + r) * 72 + 16 * s + 8 * h); sa = __builtin_amdgcn_mfma_f32_32x32x16_bf16(a, qf[m][s], sa, 0, 0, 0); }
                    float psum = 0.f;
                    if ((ch == 0 || ch == 2) && kt == dk) {
#pragma unroll
                        for (int i = 0; i < 16; ++i) { const int kk = (i & 3) + 8 * (i >> 2) + 4 * h; const bool ok = (ch == 0) ? (kk >= r) : (kk <= r); const float pv = ok ? __builtin_amdgcn_exp2f(sa[i]) : 0.f; psum += pv; sa[i] = pv; }
                    } else {
#pragma unroll
                        for (int i = 0; i < 16; ++i) { const float pv = __builtin_amdgcn_exp2f(sa[i]); psum += pv; sa[i] = pv; }
                    }
                    lrun[m] += psum;
                    bf16x8 pf[2];
#pragma unroll
                    for (int s2 = 0; s2 < 2; ++s2) { u32x4 w; w.x = pk2(sa[8 * s2], sa[8 * s2 + 1]); w.y = pk2(sa[8 * s2 + 2], sa[8 * s2 + 3]); w.z = pk2(sa[8 * s2 + 4], sa[8 * s2 + 5]); w.w = pk2(sa[8 * s2 + 6], sa[8 * s2 + 7]);
                        pf[s2] = __builtin_bit_cast(bf16x8, w); }
#pragma unroll
                    for (int s2 = 0; s2 < 2; ++s2)
#pragma unroll
                        for (int d = 0; d < 2; ++d) {
                            const bf16_t* vp = Vt + (d * 32 + r) * 132 + kt * 32 + 16 * s2 + 4 * h;
                            const s16x4 lo = *(const s16x4*)vp, hi = *(const s16x4*)(vp + 8);
                            const bf16x8 av = __builtin_shufflevector(lo, hi, 0, 1, 2, 3, 4, 5, 6, 7);
                            o[m][d] = __builtin_amdgcn_mfma_f32_32x32x16_bf16(av, pf[s2], o[m][d], 0, 0, 0);
                        }
                }
            }
            if (nch < 5) attn_stage_store((bf16_t*)(shm + (buf ^ 1) * BUFB), (bf16_t*)(shm + (buf ^ 1) * BUFB + 18432), tid, kr, vr);
            __syncthreads();
            buf ^= 1; ch = nch;
        }
        const float sinkp = __builtin_amdgcn_exp2f(p.at_sink[hd] * LOG2E + negB);
#pragma unroll
        for (int m = 0; m < 2; ++m) {
            const float il = 1.f / (lrun[m] + __shfl_xor(lrun[m], 32) + sinkp);
            bf16_t* orow = obuf + (size_t)(b * SEQ + qs + 32 * m + r) * DM + hd * 64;
#pragma unroll
            for (int d = 0; d < 2; ++d)
#pragma unroll
                for (int gq = 0; gq < 4; ++gq) { u32x2 w; w.x = pk2(o[m][d][4 * gq] * il, o[m][d][4 * gq + 1] * il); w.y = pk2(o[m][d][4 * gq + 2] * il, o[m][d][4 * gq + 3] * il);
                    *(u32x2*)(orow + d * 32 + 8 * gq + 4 * h) = w; }
        }
    }
    __syncthreads();
}

__global__ void __launch_bounds__(512, 2) fwd_megakernel(P p) {
    extern __shared__ __attribute__((aligned(16))) unsigned char shm[];
    cg::grid_group grid = cg::this_grid();
    unsigned char* ws = p.ws;
    bf16_t* hbuf = (bf16_t*)(ws + OFF_HBUF);
    bf16_t* big = (bf16_t*)(ws + OFF_BIG);
    float* cx = (float*)(ws + OFF_CX);
    const float* modv = (const float*)(ws + OFF_MOD);

#ifndef PHASE_MASK
#define PHASE_MASK 0xffffffffu
#endif
#ifndef DUP_MASK
#define DUP_MASK 0u
#endif
#define PH(n) for (int _rep = 0; _rep < (((DUP_MASK >> (n)) & 1u) ? 2 : 1); ++_rep) if ((PHASE_MASK >> (n)) & 1u)
    if (blockIdx.x == 0) { unsigned* z = (unsigned*)(ws + OFF_NORM); for (int i = threadIdx.x; i < 8192; i += 512) z[i] = 0u; }
    PH(0) phase0(p, shm);
    grid.sync();
    if (threadIdx.x == 0) { *(volatile LAS unsigned*)(LAS unsigned char*)(shm + LDS_XB) = 0u; *((volatile LAS unsigned*)(LAS unsigned char*)(shm + LDS_XB) + 1) = 0u; }
    __syncthreads();
    const XcdBarrier xb = xcd_barrier_post((unsigned*)(ws + OFF_XBAR), (volatile LAS unsigned*)(LAS unsigned char*)(shm + LDS_XB));
    PH(1) kcgen_phase(p, shm);
    PH(1) sw_phase(p, shm);
    PH(2) norm_phase(p.x, p.ctx, p.norm1_w, modv, 0, 1, hbuf, TT);
    xcd_barrier(xb);
    float* ssq = (float*)(ws + OFF_SSQ); float* ssp = (float*)(ws + OFF_SSQP); const float* swv = (const float*)(ws + OFF_SW);
    bf16_t* xgA = (bf16_t*)(ws + OFF_UT);
    const float* modv1 = modv + 9 * 6144;
    PH(3) { pg8::EpiBf16RowBias E; E.O = big; E.ldc = TT; E.bias = p.hy_b_in; run_gemm(shm, (const bf16_t*)(ws + OFF_WIN), hbuf, 3072, TT, DM, E); }
    xcd_barrier(xb);
    PH(5) fftconv_phase(p, shm);
    xcd_barrier(xb);
    PH(6) zback_phase(p, shm);
    xcd_barrier(xb);
    bf16_t* resid = (bf16_t*)p.out;
    bf16_t* cxb = (bf16_t*)cx;
    PH(7) { pg8::EpiRes<true, false, true> E; E.srcX = p.x; E.srcC = p.ctx; E.dstX = resid; E.dstC = cxb; E.bias = p.hy_b_out; E.gate = modv + 2 * 1024;
            E.xg = xgA; E.gw = p.norm2_w; E.scl = modv + 4 * 1024; E.ssq = ssp; run_gemm(shm, hbuf, (const bf16_t*)(ws + OFF_WHO), TX, DM, DM, E);
            pg8::EpiPartial Ep; Ep.part = (float*)(ws + OFF_BIG); Ep.ksplit = 4; Ep.slice = (size_t)TC * DM;
            run_gemm(shm, hbuf + (size_t)TX * DM, (const bf16_t*)(ws + OFF_WHO), TC, DM, DM / 4, Ep, DM, 4); }
    xcd_barrier(xb);
    rnorm_phase(ssp, ssq, TX);
    ctx_finalize((const float*)(ws + OFF_BIG), 4, p.ctx, p.hy_b_out, cxb, modv + 8 * 6144 + 2 * 1024, p.norm2_w, modv + 8 * 6144 + 4 * 1024, xgA + (size_t)TX * DM, ssq + TX);
    xcd_barrier(xb);
    PH(9) { pg8::EpiBf16<1, true> E; E.O = big; E.ldc = DFF; E.bias = nullptr; E.ssq = ssq; E.sw = swv; run_gemm(shm, xgA, (const bf16_t*)(ws + OFF_W1), TT, DFF, DM, E); }
    xcd_barrier(xb);
    PH(10) { pg8::EpiRes<true, true, true> E; E.srcX = resid; E.srcC = cxb; E.dstX = resid; E.dstC = cxb; E.bias = nullptr; E.gate = modv + 5 * 1024;
             E.xg = hbuf; E.gw = p.norm1_w + DM; E.scl = modv1 + 1 * 1024; E.ssq = ssp + (size_t)TT * 16; run_gemm(shm, big, (const bf16_t*)(ws + OFF_W2), TX, DM, DFF, E);
             pg8::EpiPartial Ep; Ep.part = (float*)(ws + OFF_UT); Ep.ksplit = 8; Ep.slice = (size_t)TC * DM;
             run_gemm(shm, big + (size_t)TX * DFF, (const bf16_t*)(ws + OFF_W2), TC, DM, DFF / 8, Ep, DFF, 8); }
    xcd_barrier(xb);
    rnorm_phase(ssp + (size_t)TT * 16, ssq + TT, TX);
    ctx_finalize((const float*)(ws + OFF_UT), 8, nullptr, nullptr, cxb, modv + 8 * 6144 + 5 * 1024, p.norm1_w + DM, modv1 + 8 * 6144 + 1 * 1024, hbuf + (size_t)TX * DM, ssq + TT + TX);
    xcd_barrier(xb);
    PH(12) { pg8::EpiBf16<0, true> E; E.O = big; E.ldc = 1536; E.bias = p.at_b_qkv; E.ssq = ssq + TT; E.sw = swv + 9 * 4096; run_gemm(shm, hbuf, (const bf16_t*)(ws + OFF_WQKV), TT, 1536, DM, E); }
    xcd_barrier(xb);
    PH(13) kprep_phase(p);
    xcd_barrier(xb);
    PH(14) attn_phase(p, shm);
    xcd_barrier(xb);
    bf16_t* xgB = (bf16_t*)((char*)p.out + 128 * MiB);
    PH(15) { pg8::EpiRes<true, true, true> E; E.srcX = resid; E.srcC = cxb; E.dstX = xgA; E.dstC = cxb; E.bias = p.at_b_out; E.gate = modv1 + 2 * 1024;
             E.xg = xgB; E.gw = p.norm2_w + DM; E.scl = modv1 + 4 * 1024; E.ssq = ssp + (size_t)2 * TT * 16; run_gemm(shm, hbuf, (const bf16_t*)(ws + OFF_WAO), TX, DM, DM, E); }
    xcd_barrier(xb);
    rnorm_phase(ssp + (size_t)2 * TT * 16, ssq + 2 * TT, TX);
    xcd_barrier(xb);
    PH(17) { pg8::EpiBf16<1, true> E; E.O = big; E.ldc = DFF; E.bias = nullptr; E.ssq = ssq + 2 * TT; E.sw = swv + 2 * 9 * 4096; run_gemm(shm, xgB, (const bf16_t*)(ws + OFF_W1) + (size_t)DM * DFF, TX, DFF, DM, E); }
    xcd_barrier(xb);
    PH(18) { pg8::EpiRes<false, true, false> E; E.srcX = xgA; E.srcC = cxb; E.dstX = p.out; E.dstC = cx; E.bias = nullptr; E.gate = modv1 + 5 * 1024;
             E.xg = nullptr; E.gw = nullptr; E.scl = nullptr; E.ssq = nullptr; run_gemm(shm, big, (const bf16_t*)(ws + OFF_W2) + (size_t)DM * DFF, TX, DM, DFF, E); }
}

extern "C" void kernel_launch(void* const* d_in, const int* in_sizes, int n_in, void* d_out, int out_size, void* d_ws, size_t ws_size, hipStream_t stream) {
    static int grid_blocks = 0;
    if (grid_blocks == 0) {
        if (n_in != 31 || ws_size < WS_END) { fprintf(stderr, "kernel_launch: unexpected n_in %d or ws_size %zu (< %zu)\n", n_in, ws_size, (size_t)WS_END); grid_blocks = -1; return; }
        int dev = 0, cus = 0, per_cu = 0;
        hipGetDevice(&dev);
        hipDeviceGetAttribute(&cus, hipDeviceAttributeMultiprocessorCount, dev);
        if (hipFuncSetAttribute((const void*)fwd_megakernel, hipFuncAttributeMaxDynamicSharedMemorySize, LDS_BYTES) != hipSuccess) { fprintf(stderr, "kernel_launch: hipFuncSetAttribute failed\n"); }
        hipOccupancyMaxActiveBlocksPerMultiprocessor(&per_cu, (const void*)fwd_megakernel, 512, LDS_BYTES);
        if (per_cu < 1) { fprintf(stderr, "kernel_launch: occupancy query gave %d\n", per_cu); per_cu = 1; }
        if (per_cu > 1) per_cu = 1;
        (void)hipGetLastError();
        grid_blocks = cus * per_cu;
    }
    if (grid_blocks < 0) return;
    P p{};
    const float** pp = (const float**)&p;
    for (int i = 0; i < 31; ++i) pp[i] = (const float*)d_in[i];
    p.out = (float*)d_out; p.ws = (unsigned char*)d_ws;
    void* args[] = {&p};
    hipError_t e = hipLaunchCooperativeKernel((const void*)fwd_megakernel, dim3(grid_blocks), dim3(512), args, LDS_BYTES, stream);
    if (e != hipSuccess) fprintf(stderr, "cooperative launch failed: %s (grid %d)\n", hipGetErrorString(e), grid_blocks);
}
```

```cpp
#include <hip/hip_runtime.h>
#include <hip/hip_cooperative_groups.h>
#include <cstdio>
namespace cg = cooperative_groups;

#define DI __device__ __forceinline__
#define LAS __attribute__((address_space(3)))
typedef unsigned short bf16_t;
typedef short bf16x8 __attribute__((ext_vector_type(8)));
typedef short s16x4 __attribute__((ext_vector_type(4)));
typedef float f32x4 __attribute__((ext_vector_type(4)));
typedef float f32x16 __attribute__((ext_vector_type(16)));
typedef unsigned u32x4 __attribute__((ext_vector_type(4)));
typedef unsigned u32x2 __attribute__((ext_vector_type(2)));
typedef __bf16 bf2_t __attribute__((ext_vector_type(2)));
typedef float f2_t __attribute__((ext_vector_type(2)));

constexpr int NB = 8, SEQ = 8192, DM = 1024, CL = 256, TX = NB * SEQ, TC = NB * CL, TT = TX + TC, DFF = 4096;
constexpr int LDS_XB = 128 * 129 * 8;
constexpr int LDS_SPARE = LDS_XB + 16;
constexpr int LDS_SRC0 = LDS_SPARE + 2 * 4096;
constexpr int LDS_BYTES = LDS_SRC0 + 8 * 2048;
constexpr float EPS = 1e-6f;
constexpr float LOG2E = 1.4426950408889634f;

constexpr size_t MiB = 1024 * 1024;
constexpr size_t OFF_WIN = 0;
constexpr size_t OFF_WHO = OFF_WIN + 6 * MiB;
constexpr size_t OFF_W1 = OFF_WHO + 2 * MiB;
constexpr size_t OFF_W2 = OFF_W1 + 16 * MiB;
constexpr size_t OFF_WQKV = OFF_W2 + 16 * MiB;
constexpr size_t OFF_WAO = OFF_WQKV + 3 * MiB;
constexpr size_t OFF_MOD = OFF_WAO + 2 * MiB;
constexpr size_t OFF_H2 = OFF_MOD + MiB / 2;
constexpr size_t OFF_H2C = OFF_H2 + 2 * MiB;
constexpr size_t OFF_NORM = OFF_H2C + 65536;
constexpr size_t OFF_XBAR = OFF_NORM + 16384;
constexpr size_t OFF_KCU = OFF_NORM + 65536;
constexpr size_t OFF_KCUC = OFF_KCU + 64 * MiB;
constexpr size_t OFF_KSCR = OFF_KCUC + 2 * MiB;
constexpr size_t OFF_CX = OFF_KSCR + 34 * MiB;
constexpr size_t OFF_HBUF = OFF_CX + 8 * MiB;
constexpr size_t OFF_UT = OFF_HBUF + 132 * MiB;
constexpr size_t OFF_UTC = OFF_UT + 128 * MiB;
constexpr size_t OFF_BIG = OFF_UTC + 4 * MiB;
constexpr size_t OFF_X0C = OFF_BIG + 396 * MiB;
constexpr size_t OFF_SSQ = OFF_BIG + 528 * MiB;
constexpr size_t OFF_SW = OFF_SSQ + MiB;
constexpr size_t OFF_SSQP = OFF_SW + MiB;
constexpr size_t WS_END = OFF_SSQP + 13 * MiB;

struct P {
    const float *x, *c, *ctx, *c_ctx, *mod_w, *mod_b, *norm1_w, *norm2_w, *mlp_w1, *mlp_w2, *hy_w_in, *hy_b_in, *hy_conv_w, *hy_conv_b, *hy_f_w1, *hy_f_b1, *hy_f_fr1, *hy_f_w2,
        *hy_f_b2, *hy_f_fr2, *hy_f_w3, *hy_skip, *hy_w_out, *hy_b_out, *at_w_qkv, *at_b_qkv, *at_q_norm, *at_k_norm, *at_sink, *at_w_out, *at_b_out;
    float* out;
    unsigned char* ws;
};

DI unsigned pk2(float lo, float hi) { f2_t v = {lo, hi}; bf2_t r = __builtin_convertvector(v, bf2_t); return __builtin_bit_cast(unsigned, r); }
DI float bf_lo(unsigned u) { return __uint_as_float(u << 16); }
DI float bf_hi(unsigned u) { return __uint_as_float(u & 0xffff0000u); }
DI float bf1(bf16_t b) { return __uint_as_float(((unsigned)b) << 16); }
DI bf16_t f2bf(float f) { return (bf16_t)(pk2(f, 0.f) & 0xffffu); }
DI float wave_sum(float v) {
#pragma unroll
    for (int o = 1; o < 64; o <<= 1) v += __shfl_xor(v, o);
    return v;
}
template <int CTRL> DI float dpp_mov(float v) { return __builtin_bit_cast(float, __builtin_amdgcn_update_dpp(0, __builtin_bit_cast(int, v), CTRL, 0xF, 0xF, true)); }
DI int otid() { int t = threadIdx.x; asm volatile("" : "+v"(t)); return t; }
DI void unpack8(const u32x4 w, float (&f)[8]) { f[0] = bf_lo(w.x); f[1] = bf_hi(w.x); f[2] = bf_lo(w.y); f[3] = bf_hi(w.y); f[4] = bf_lo(w.z); f[5] = bf_hi(w.z); f[6] = bf_lo(w.w); f[7] = bf_hi(w.w); }
DI u32x4 pack8(const float (&f)[8]) { u32x4 w; w.x = pk2(f[0], f[1]); w.y = pk2(f[2], f[3]); w.z = pk2(f[4], f[5]); w.w = pk2(f[6], f[7]); return w; }

#define XB_TMO      128
#define XB_XCNT(j)  (256  + 64 * (j))
#define XB_XSUB(j)  (1280 + 64 * (j))
#define XB_XGEN(j)  (2304 + 64 * (j))
#define XB_TOP      3328
#define XB_TOPGEN   3392
#define XCD_BAR_WORDS 3456
#define XB_SPIN_CAP (1u << 18)
DI unsigned xb_ld(unsigned* p)              { return __hip_atomic_load(p, __ATOMIC_RELAXED, __HIP_MEMORY_SCOPE_AGENT); }
DI unsigned xb_add(unsigned* p, unsigned v) { return __hip_atomic_fetch_add(p, v, __ATOMIC_RELAXED, __HIP_MEMORY_SCOPE_AGENT); }
DI unsigned xb_xcc_id() { return (unsigned)__builtin_amdgcn_s_getreg((3 << 11) | 20) & 0xFu; }
#define XB_SPIN(cond, bar) do { unsigned _sp = 0; while (cond) { __builtin_amdgcn_s_sleep(1); \
    if ((++_sp & 255u) == 0u) { if (xb_ld(&(bar)[XB_TMO])) break; if (_sp > XB_SPIN_CAP) { atomicAdd(&(bar)[XB_TMO], 1u); break; } } } } while (0)
struct XcdBarrier { unsigned* bar; unsigned x; volatile LAS unsigned* st; };
DI XcdBarrier xcd_barrier_post(unsigned* bar, volatile LAS unsigned* st) {
    XcdBarrier b; b.bar = bar; b.x = xb_xcc_id(); b.st = st;
    if (threadIdx.x == 0) (void)xb_add(&bar[XB_XCNT(b.x)], 1u);
    return b;
}
DI void xcd_barrier_complete(unsigned* bar, unsigned x, unsigned& nloc, unsigned& nx) {
    const unsigned G = gridDim.x * gridDim.y * gridDim.z;
    unsigned sum, cnt, mine, sp = 0u;
    for (;;) {
        sum = 0u; cnt = 0u; mine = 0u;
#pragma unroll
        for (unsigned j = 0; j < 16; ++j) { const unsigned c = xb_ld(&bar[XB_XCNT(j)]); sum += c; cnt += (c > 0u) ? 1u : 0u; mine = (j == x) ? c : mine; }
        if (sum == G) break;
        __builtin_amdgcn_s_sleep(1);
        if ((++sp & 255u) == 0u) { if (xb_ld(&bar[XB_TMO])) break; if (sp > XB_SPIN_CAP) { atomicAdd(&bar[XB_TMO], 1u); break; } }
    }
    nloc = mine > 0u ? mine : 1u; nx = cnt > 0u ? cnt : 1u;
}
DI void xcd_barrier(const XcdBarrier& b) {
    asm volatile("s_waitcnt vmcnt(0)" ::: "memory");
    __syncthreads();
    if (threadIdx.x == 0) {
        unsigned* bar = b.bar;
        __builtin_amdgcn_s_waitcnt(0);
        unsigned nloc = b.st[0], nx = b.st[1];
        if (nloc == 0u) { xcd_barrier_complete(bar, b.x, nloc, nx); b.st[0] = nloc; b.st[1] = nx; }
        const unsigned old = xb_add(&bar[XB_XSUB(b.x)], 1u);
        const unsigned gen = old / nloc;
        if (old + 1u == (gen + 1u) * nloc) {
            __builtin_amdgcn_fence(__ATOMIC_RELEASE, "agent");
            asm volatile("s_waitcnt vmcnt(0)" ::: "memory");
            const unsigned og = xb_add(&bar[XB_TOP], 1u);
            const unsigned tg = og / nx;
            if (og + 1u == (tg + 1u) * nx) xb_add(&bar[XB_TOPGEN], 1u);
            else XB_SPIN(xb_ld(&bar[XB_TOPGEN]) == tg, bar);
            __builtin_amdgcn_fence(__ATOMIC_ACQUIRE, "agent");
            xb_add(&bar[XB_XGEN(b.x)], 1u);
            asm volatile("s_waitcnt vmcnt(0)" ::: "memory");
        } else {
            XB_SPIN(xb_ld(&bar[XB_XGEN(b.x)]) == gen, bar);
            __builtin_amdgcn_fence(__ATOMIC_ACQUIRE, "agent");
            asm volatile("s_waitcnt vmcnt(0)" ::: "memory");
        }
    }
    __syncthreads();
}

namespace pg8 {
constexpr int BM = 256, BK = 64, HALF = 128, HTB = HALF * BK * 2, STAGE_BYTES = 8 * HTB, NXCD = 8, WGM = 8;
DI int lds_byte(int r, int c) { const int st = (r >> 4) * 2 + (c >> 5), rr = r & 15, cc = c & 31, ob = rr * 64 + cc * 2; return st * 1024 + (ob ^ (((ob >> 9) & 1) << 5)); }
DI void stage_rc(int b, int& R, int& C) { const int st = b / 1024, sb = b % 1024, swz = sb ^ (((sb >> 9) & 1) << 5); R = (st >> 1) * 16 + swz / 64; C = (st & 1) * 32 + (swz % 64) / 2; }
DI int perm32(int rho) { const int n = rho >> 4, i = rho & 15; return 8 * (i >> 2) + 4 * n + (i & 3); }
struct Unit { int pm, pn; };
struct Gemm { const bf16_t* A; const bf16_t* Bt; int M, N, K; int ld; int ksplit; };
struct StaticOrder {
    int nM, nN, nwg, G, c;
    DI void init(int M, int N, int G_, int c_) { nM = M / BM; nN = N / BM; nwg = nM * nN; G = G_; c = c_; }
    DI bool next(int i, Unit& u) const {
        const long L = (long)i * G + c; if (L >= nwg) return false;
        int wgid = (int)L; { const int q = nwg / NXCD, r = nwg % NXCD, xcd = wgid % NXCD, off = wgid / NXCD; wgid = (xcd < r ? xcd * (q + 1) : r * (q + 1) + (xcd - r) * q) + off; }
        const int nig = WGM * nN, gid = wgid / nig, fm = gid * WGM, gsz = (nM - fm) < WGM ? (nM - fm) : WGM;
        u.pm = fm + ((wgid % nig) % gsz); u.pn = (wgid % nig) / gsz; return true;
    }
};
template <int ACT  , bool NORM> struct EpiBf16 {
    static constexpr bool PERM = true;
    static constexpr bool PREFETCH_SRC = false;
    static constexpr bool PREFETCH = NORM;
    bf16_t* O; int ldc; const float* bias; const float* ssq; const float* sw;
    DI void prefetch(LAS unsigned char* sp, const Unit& u, int wid, int lane) const {
        if (wid > 2) return;
        const int mi = (u.pm < (TX / BM)) ? (u.pm >> 5) : 8;
        const float* base = (wid == 0) ? sw + mi * 4096 + u.pn * BM : (wid == 1) ? ssq + u.pm * BM : ((ACT == 0) ? bias + u.pn * BM : sw);
        unsigned lo = (unsigned)lane * 16u; asm volatile("" : "+v"(lo));
        if (wid < 2 || ACT == 0) __builtin_amdgcn_global_load_lds((const unsigned*)((const char*)base + lo), (LAS unsigned*)(sp + wid * 1024), 16, 0, 0);
    }
    DI void run(const f32x4 (&acc)[2][2][4][2], const Unit& u, int wr, int wc, int fr, int fq, const LAS unsigned char* sp) const {
        const int row0 = u.pm * BM + wr * 64 + fr; const int col0 = u.pn * BM + wc * 32 + 8 * fq;
        const int lc = wc * 32 + 8 * fq, lr = wr * 64 + fr;
        f32x4 bv[2][2];
#pragma unroll
        for (int bj = 0; bj < 2; ++bj)
#pragma unroll
            for (int n = 0; n < 2; ++n) { bv[bj][n] = *(const LAS f32x4*)(sp + (lc + bj * HALF + 4 * n) * 4);
                if (ACT == 0) bv[bj][n] += *(const LAS f32x4*)(sp + 2048 + (lc + bj * HALF + 4 * n) * 4); }
#pragma unroll
        for (int ai = 0; ai < 2; ++ai)
#pragma unroll
            for (int m = 0; m < 4; ++m) { const int row = row0 + ai * HALF + m * 16; bf16_t* rowp = O + (size_t)row * ldc + col0;
                const float r = *(const LAS float*)(sp + 1024 + (lr + ai * HALF + m * 16) * 4);
#pragma unroll
                for (int bj = 0; bj < 2; ++bj) { f32x4 v0 = acc[ai][bj][m][0] * r + bv[bj][0], v1 = acc[ai][bj][m][1] * r + bv[bj][1];
                    if (ACT == 1) {
#pragma unroll
                        for (int j = 0; j < 4; ++j) { const float a = fmaxf(v0[j], 0.f), b = fmaxf(v1[j], 0.f); v0[j] = a * a; v1[j] = b * b; } }
                    u32x4 w; w.x = pk2(v0[0], v0[1]); w.y = pk2(v0[2], v0[3]); w.z = pk2(v1[0], v1[1]); w.w = pk2(v1[2], v1[3]);
                    *(u32x4*)(rowp + bj * HALF) = w; } }
    }
    DI void operator()(const f32x4 (&acc)[2][2][4][2], const Unit& u, int wr, int wc, int fr, int fq) const {
        const int row0 = u.pm * BM + wr * 64 + fr; const int col0 = u.pn * BM + wc * 32 + 8 * fq;
        const int mi = (u.pm < (TX / BM)) ? (u.pm >> 5) : 8;
        f32x4 bv[2][2];
#pragma unroll
        for (int bj = 0; bj < 2; ++bj)
#pragma unroll
            for (int n = 0; n < 2; ++n) { bv[bj][n] = (ACT == 0) ? *(const f32x4*)(bias + col0 + bj * HALF + 4 * n) : (f32x4){0.f, 0.f, 0.f, 0.f};
                if (NORM) bv[bj][n] += *(const f32x4*)(sw + mi * 4096 + col0 + bj * HALF + 4 * n); }
#pragma unroll
        for (int ai = 0; ai < 2; ++ai)
#pragma unroll
            for (int m = 0; m < 4; ++m) { const int row = row0 + ai * HALF + m * 16; bf16_t* rowp = O + (size_t)row * ldc + col0;
                const float r = NORM ? ssq[row] : 1.f;
#pragma unroll
                for (int bj = 0; bj < 2; ++bj) { f32x4 v0 = acc[ai][bj][m][0] * r + bv[bj][0], v1 = acc[ai][bj][m][1] * r + bv[bj][1];
                    if (ACT == 1) {
#pragma unroll
                        for (int j = 0; j < 4; ++j) { const float a = fmaxf(v0[j], 0.f), b = fmaxf(v1[j], 0.f); v0[j] = a * a; v1[j] = b * b; } }
                    u32x4 w; w.x = pk2(v0[0], v0[1]); w.y = pk2(v0[2], v0[3]); w.z = pk2(v1[0], v1[1]); w.w = pk2(v1[2], v1[3]);
                    *(u32x4*)(rowp + bj * HALF) = w; } }
    }
};
struct EpiBf16RowBias {
    static constexpr bool PERM = true; static constexpr bool PREFETCH = true; static constexpr bool PREFETCH_SRC = false;
    bf16_t* O; size_t ldc; const float* bias;
    DI void prefetch(LAS unsigned char* sp, const Unit& u, int wid, int lane) const {
        if (wid != 0) return;
        unsigned lo = (unsigned)lane * 16u; asm volatile("" : "+v"(lo));
        __builtin_amdgcn_global_load_lds((const unsigned*)((const char*)(bias + u.pm * BM) + lo), (LAS unsigned*)sp, 16, 0, 0);
    }
    DI void run(const f32x4 (&acc)[2][2][4][2], const Unit& u, int wr, int wc, int fr, int fq, const LAS unsigned char* sp) const {
        const int row0 = u.pm * BM + wr * 64 + fr; const int col0 = u.pn * BM + wc * 32 + 8 * fq;
#pragma unroll
        for (int ai = 0; ai < 2; ++ai)
#pragma unroll
            for (int m = 0; m < 4; ++m) { const int row = row0 + ai * HALF + m * 16; const float bs = *(const LAS float*)(sp + (wr * 64 + fr + ai * HALF + m * 16) * 4); bf16_t* rowp = O + (size_t)row * ldc + col0;
#pragma unroll
                for (int bj = 0; bj < 2; ++bj) { const f32x4 v0 = acc[ai][bj][m][0] + bs, v1 = acc[ai][bj][m][1] + bs;
                    u32x4 w; w.x = pk2(v0[0], v0[1]); w.y = pk2(v0[2], v0[3]); w.z = pk2(v1[0], v1[1]); w.w = pk2(v1[2], v1[3]);
                    *(u32x4*)(rowp + bj * HALF) = w; } }
    }
};
struct EpiPartial {
    static constexpr bool PERM = true; static constexpr bool PREFETCH = false; static constexpr bool PREFETCH_SRC = false;
    float* part; int ksplit; size_t slice;
    DI void operator()(const f32x4 (&acc)[2][2][4][2], const Unit& u, int wr, int wc, int fr, int fq) const {
        const int pn = u.pn / ksplit, ks = u.pn % ksplit;
        const int row0 = u.pm * BM + wr * 64 + fr, col0 = pn * BM + wc * 32 + 8 * fq;
        float* base = part + (size_t)ks * slice;
#pragma unroll
        for (int ai = 0; ai < 2; ++ai)
#pragma unroll
            for (int m = 0; m < 4; ++m) { float* rowp = base + (size_t)(row0 + ai * HALF + m * 16) * DM + col0;
#pragma unroll
                for (int bj = 0; bj < 2; ++bj) { *(f32x4*)(rowp + bj * HALF) = acc[ai][bj][m][0]; *(f32x4*)(rowp + bj * HALF + 4) = acc[ai][bj][m][1]; } }
    }
};
template <bool FUSE, bool SRCBF, bool DSTBF> struct EpiRes {
    static constexpr bool PERM = true; static constexpr bool PREFETCH = true; static constexpr bool PREFETCH_SRC = true;
    const void* srcX; const void* srcC; void* dstX; void* dstC; const float* bias; const float* gate;
    bf16_t* xg; const float* gw; const float* scl; float* ssq;
    DI void ld_src(const void* base, size_t off, f32x4& lo, f32x4& hi) const {
        if (SRCBF) { const u32x4 w = *(const u32x4*)((const bf16_t*)base + off); lo = (f32x4){bf_lo(w.x), bf_hi(w.x), bf_lo(w.y), bf_hi(w.y)}; hi = (f32x4){bf_lo(w.z), bf_hi(w.z), bf_lo(w.w), bf_hi(w.w)}; }
        else { lo = *(const f32x4*)((const float*)base + off); hi = *(const f32x4*)((const float*)base + off + 4); }
    }
    DI void prefetch(LAS unsigned char* sp, const Unit& u, int wid, int lane) const {
        if (wid > 3) return;
        const int mi = (u.pm < (TX / BM)) ? (u.pm >> 5) : 8;
        const float* base = (wid == 0) ? gate + mi * 6144 + u.pn * BM : (wid == 1) ? (bias ? bias : gate) + u.pn * BM : (wid == 2) ? (FUSE ? gw : gate) + u.pn * BM : (FUSE ? scl : gate) + mi * 6144 + u.pn * BM;
        unsigned lo = (unsigned)lane * 16u; asm volatile("" : "+v"(lo));
        if (wid == 0 || (wid == 1 && bias) || (wid >= 2 && FUSE)) __builtin_amdgcn_global_load_lds((const unsigned*)((const char*)base + lo), (LAS unsigned*)(sp + wid * 1024), 16, 0, 0);
    }
    DI void prefetch_src(LAS unsigned char* slot, const Unit& u, int wid, int lane) const {
        if (!SRCBF) return;
        const int wr = wid >> 2, wc = wid & 3; int fr = lane & 15, fq = lane >> 4; asm volatile("" : "+v"(fr), "+v"(fq));
        const bf16_t* src = (u.pm < (TX / BM)) ? (const bf16_t*)srcX : (const bf16_t*)srcC - (size_t)TX * DM;
        const bf16_t* p0 = src + (size_t)(u.pm * BM + wr * 64 + fr) * DM + u.pn * BM + wc * 32 + 8 * fq;
        __builtin_amdgcn_global_load_lds((const unsigned*)p0, (LAS unsigned*)slot, 16, 0, 0);
        __builtin_amdgcn_global_load_lds((const unsigned*)(p0 + HALF), (LAS unsigned*)(slot + 1024), 16, 0, 0);
    }
    DI void run(const f32x4 (&acc)[2][2][4][2], const Unit& u, int wr, int wc, int fr, int fq, const LAS unsigned char* sp, const LAS unsigned char* slot, int lane) const {
        const bool lat = u.pm < (TX / BM);
        const int mi = lat ? (u.pm >> 5) : 8;
        const void* src = lat ? srcX : (const void*)((const char*)srcC - (size_t)TX * DM * (SRCBF ? 2 : 4));
        void* dst = lat ? dstX : (void*)((char*)dstC - (size_t)TX * DM * (DSTBF ? 2 : 4));
        const int row0 = u.pm * BM + wr * 64 + fr, col0 = u.pn * BM + wc * 32 + 8 * fq;
        f32x4 gv[2][2], gb[2][2], gs[2][2];
#pragma unroll
        for (int bj = 0; bj < 2; ++bj)
#pragma unroll
            for (int n = 0; n < 2; ++n) { const int lo4 = (wc * 32 + 8 * fq + bj * HALF + 4 * n) * 4; gv[bj][n] = *(const LAS f32x4*)(sp + lo4);
                gb[bj][n] = bias ? gv[bj][n] * *(const LAS f32x4*)(sp + 1024 + lo4) : (f32x4){0.f, 0.f, 0.f, 0.f};
                if (FUSE) gs[bj][n] = *(const LAS f32x4*)(sp + 2048 + lo4) * (*(const LAS f32x4*)(sp + 3072 + lo4) + 1.f); }
        f32x4 sv[2][2];
        if (SRCBF) {
#pragma unroll
            for (int bj = 0; bj < 2; ++bj) { const u32x4 w = *(const LAS u32x4*)(slot + bj * 1024 + lane * 16);
                sv[bj][0] = (f32x4){bf_lo(w.x), bf_hi(w.x), bf_lo(w.y), bf_hi(w.y)}; sv[bj][1] = (f32x4){bf_lo(w.z), bf_hi(w.z), bf_lo(w.w), bf_hi(w.w)}; }
        } else { const size_t ro = (size_t)row0 * DM + col0;
#pragma unroll
            for (int bj = 0; bj < 2; ++bj) ld_src(src, ro + bj * HALF, sv[bj][0], sv[bj][1]); }
#pragma unroll
        for (int it = 0; it < 8; ++it) { const int ai = it >> 2, m = it & 3; const int row = row0 + ai * HALF + m * 16; const size_t ro = (size_t)row * DM + col0;
            const size_t rn = (size_t)(row0 + ((it + 1) >> 2) * HALF + ((it + 1) & 3) * 16) * DM + col0;
            float ss = 0.f;
#pragma unroll
            for (int bj = 0; bj < 2; ++bj) {
                f32x4 o[2];
#pragma unroll
                for (int n = 0; n < 2; ++n) o[n] = sv[bj][n] + gv[bj][n] * acc[ai][bj][m][n] + gb[bj][n];
                if (it + 1 < 8) ld_src(src, rn + bj * HALF, sv[bj][0], sv[bj][1]);
                const size_t eo = ro + bj * HALF;
                if (DSTBF) { u32x4 w; w.x = pk2(o[0].x, o[0].y); w.y = pk2(o[0].z, o[0].w); w.z = pk2(o[1].x, o[1].y); w.w = pk2(o[1].z, o[1].w); *(u32x4*)((bf16_t*)dst + eo) = w; }
                else { *(f32x4*)((float*)dst + eo) = o[0]; *(f32x4*)((float*)dst + eo + 4) = o[1]; }
                if (FUSE) {
#pragma unroll
                    for (int n = 0; n < 2; ++n) ss += (o[n].x * o[n].x + o[n].y * o[n].y) + (o[n].z * o[n].z + o[n].w * o[n].w);
                    const f32x4 t0 = o[0] * gs[bj][0], t1 = o[1] * gs[bj][1];
                    u32x4 w; w.x = pk2(t0.x, t0.y); w.y = pk2(t0.z, t0.w); w.z = pk2(t1.x, t1.y); w.w = pk2(t1.z, t1.w); *(u32x4*)(xg + eo) = w; }
            }
            if (FUSE) { ss += __shfl_xor(ss, 16); ss += __shfl_xor(ss, 32); if (fq == 0) ssq[(size_t)row * 16 + u.pn * 4 + wc] = ss; } }
    }
};

template <class Epi>
DI void gemm_phase(LAS unsigned char* lds, const Gemm g, const StaticOrder& S, const Epi& E) {
    const int tid = otid(), wid = __builtin_amdgcn_readfirstlane(tid >> 6), lane = tid & 63, wr = wid >> 2, wc = wid & 3, fr = lane & 15, fq = lane >> 4;
    const int K = g.K, nt = K / BK, LD = g.ld, KS = g.ksplit;
    unsigned voffA[2], voffB[2];
#pragma unroll
    for (int i = 0; i < 2; ++i) { int R, C; stage_rc(tid * 16 + i * 8192, R, C); const int Rb = Epi::PERM ? ((R & ~31) + perm32(R & 31)) : R;
        voffA[i] = (unsigned)(R * LD + C) * 2u; voffB[i] = (unsigned)(Rb * LD + C) * 2u; }
    const size_t kstep = (size_t)(BK * 2);
    const size_t hstep = (size_t)HALF * LD * 2;
    const size_t kslice = (size_t)K * 2;
    const size_t tstep = 2 * hstep;
    const unsigned ldsw = (unsigned)wid * 1024u;
    const int aoff = lds_byte(wr * 64 + fr, fq * 8), boff = lds_byte(wc * 32 + fr, fq * 8);
#define PG8_SA(b, h) (((b) * 2 + (h)) * HTB)
#define PG8_SB(b, h) ((4 + (b) * 2 + (h)) * HTB)
#define PG8_STAGE(bufoff, gbase, voff) do { _Pragma("unroll") for (int _i = 0; _i < 2; ++_i) \
        __builtin_amdgcn_global_load_lds((const unsigned*)((const char*)(gbase) + (voff)[_i]), (LAS unsigned*)(lds + (bufoff) + ldsw + _i * 8192), 16, 0, 0); } while (0)
#define PG8_LDA(dst, b, h) do { _Pragma("unroll") for (int m = 0; m < 4; ++m) _Pragma("unroll") for (int k = 0; k < 2; ++k) dst[m][k] = *(const LAS bf16x8*)(lds + PG8_SA(b, h) + aoff + m * 2048 + k * 1024); } while (0)
#define PG8_LDB(dst, b, h) do { _Pragma("unroll") for (int n = 0; n < 2; ++n) _Pragma("unroll") for (int k = 0; k < 2; ++k) dst[n][k] = *(const LAS bf16x8*)(lds + PG8_SB(b, h) + boff + n * 2048 + k * 1024); } while (0)
#define PG8_MMA(ai, bj, At, Bt) do { __builtin_amdgcn_s_setprio(1); _Pragma("unroll") for (int m = 0; m < 4; ++m) _Pragma("unroll") for (int n = 0; n < 2; ++n) _Pragma("unroll") for (int k = 0; k < 2; ++k) \
        acc[ai][bj][m][n] = __builtin_amdgcn_mfma_f32_16x16x32_bf16(Bt[n][k], At[m][k], acc[ai][bj][m][n], 0, 0, 0); __builtin_amdgcn_s_setprio(0); } while (0)
#define PG8_WAIT_V(n) asm volatile("s_waitcnt vmcnt(" #n ")" ::: "memory")
#define PG8_WAIT_L(n) asm volatile("s_waitcnt lgkmcnt(" #n ")" ::: "memory")
#define PG8_BAR __builtin_amdgcn_s_barrier()
#define PG8_SCHED __builtin_amdgcn_sched_barrier(0)
    Unit cur, nxt; int ui = 0;
    if (!S.next(0, cur)) return;
    f32x4 acc[2][2][4][2];
#pragma unroll
    for (int a = 0; a < 2; ++a)
#pragma unroll
        for (int b = 0; b < 2; ++b)
#pragma unroll
            for (int m = 0; m < 4; ++m)
#pragma unroll
                for (int n = 0; n < 2; ++n) acc[a][b][m][n] = (f32x4){0.f, 0.f, 0.f, 0.f};
    bf16x8 At[4][2], B0[2][2], B1[2][2];
    const char* cA = (const char*)g.A + (size_t)cur.pm * tstep + (size_t)(cur.pn % KS) * kslice; const char* cB = (const char*)g.Bt + (size_t)(cur.pn / KS) * tstep + (size_t)(cur.pn % KS) * kslice;
    PG8_STAGE(PG8_SB(0, 0), cB, voffB); PG8_STAGE(PG8_SA(0, 0), cA, voffA); PG8_STAGE(PG8_SB(0, 1), cB + hstep, voffB); PG8_STAGE(PG8_SA(0, 1), cA + hstep, voffA);
    if (wr == 1) PG8_BAR;
    PG8_WAIT_V(4); PG8_BAR;
    PG8_STAGE(PG8_SB(1, 0), cB + kstep, voffB); PG8_STAGE(PG8_SA(1, 0), cA + kstep, voffA); PG8_STAGE(PG8_SB(1, 1), cB + hstep + kstep, voffB);
    PG8_WAIT_V(6); PG8_BAR;
    for (;;) {
        const bool has_next = S.next(ui + 1, nxt);
        const char* nA = has_next ? (const char*)g.A + (size_t)nxt.pm * tstep + (size_t)(nxt.pn % KS) * kslice : cA; const char* nB = has_next ? (const char*)g.Bt + (size_t)(nxt.pn / KS) * tstep + (size_t)(nxt.pn % KS) * kslice : cB;
        if constexpr (Epi::PREFETCH_SRC) E.prefetch_src(lds + LDS_SRC0 + wid * 2048, cur, wid, lane);
        if constexpr (Epi::PREFETCH) E.prefetch(lds + LDS_SPARE + (ui & 1) * 4096, cur, wid, lane);
        for (int t = 0; t < nt; t += 2) {
            const bool last = (t == nt - 2);
            const char* a1 = cA + (size_t)(t + 1) * kstep;
            const char* a2 = last ? nA : cA + (size_t)(t + 2) * kstep; const char* b2 = last ? nB : cB + (size_t)(t + 2) * kstep;
            const char* a3 = a2 + kstep; const char* b3 = b2 + kstep;
            PG8_LDB(B0, 0, 0); PG8_SCHED; PG8_LDA(At, 0, 0); PG8_STAGE(PG8_SA(1, 1), a1 + hstep, voffA);
            PG8_WAIT_L(8); PG8_BAR; PG8_WAIT_L(0); PG8_MMA(0, 0, At, B0); PG8_BAR; PG8_SCHED;
            PG8_LDB(B1, 0, 1); PG8_STAGE(PG8_SB(0, 0), b2, voffB);
            PG8_BAR; PG8_WAIT_L(0); PG8_MMA(0, 1, At, B1); PG8_BAR;
            PG8_LDA(At, 0, 1); PG8_STAGE(PG8_SA(0, 0), a2, voffA);
            PG8_BAR; PG8_WAIT_L(0); PG8_MMA(1, 0, At, B0); PG8_BAR; PG8_SCHED;
            PG8_STAGE(PG8_SB(0, 1), b2 + hstep, voffB);
            PG8_WAIT_V(6); PG8_BAR; PG8_MMA(1, 1, At, B1); PG8_BAR;
            PG8_LDB(B0, 1, 0); PG8_SCHED; PG8_LDA(At, 1, 0); PG8_STAGE(PG8_SA(0, 1), a2 + hstep, voffA);
            PG8_WAIT_L(8); PG8_BAR; PG8_WAIT_L(0); PG8_MMA(0, 0, At, B0); PG8_BAR; PG8_SCHED;
            PG8_LDB(B1, 1, 1); PG8_STAGE(PG8_SB(1, 0), b3, voffB);
            PG8_BAR; PG8_WAIT_L(0); PG8_MMA(0, 1, At, B1); PG8_BAR;
            PG8_LDA(At, 1, 1); PG8_STAGE(PG8_SA(1, 0), a3, voffA);
            PG8_BAR; PG8_WAIT_L(0); PG8_MMA(1, 0, At, B0); PG8_BAR; PG8_SCHED;
            PG8_STAGE(PG8_SB(1, 1), b3 + hstep, voffB);
            PG8_WAIT_V(6); PG8_BAR; PG8_MMA(1, 1, At, B1); PG8_BAR;
        }
        if constexpr (Epi::PREFETCH_SRC) E.run(acc, cur, wr, wc, fr, fq, lds + LDS_SPARE + (ui & 1) * 4096, lds + LDS_SRC0 + wid * 2048, lane);
        else if constexpr (Epi::PREFETCH) E.run(acc, cur, wr, wc, fr, fq, lds + LDS_SPARE + (ui & 1) * 4096); else E(acc, cur, wr, wc, fr, fq);
        if (!has_next) break;
#pragma unroll
        for (int a = 0; a < 2; ++a)
#pragma unroll
            for (int b = 0; b < 2; ++b)
#pragma unroll
                for (int m = 0; m < 4; ++m)
#pragma unroll
                    for (int n = 0; n < 2; ++n) acc[a][b][m][n] = (f32x4){0.f, 0.f, 0.f, 0.f};
        cur = nxt; cA = nA; cB = nB; ++ui;
    }
    PG8_WAIT_V(0);
    if (wr == 0) PG8_BAR;
    PG8_BAR;
#undef PG8_SA
#undef PG8_SB
#undef PG8_STAGE
#undef PG8_LDA
#undef PG8_LDB
#undef PG8_MMA
#undef PG8_WAIT_V
#undef PG8_WAIT_L
#undef PG8_BAR
#undef PG8_SCHED
}
}

template <class Epi> DI void run_gemm(unsigned char* shm, const bf16_t* A, const bf16_t* Bt, int M, int N, int K, const Epi& E, int ld = 0, int ksplit = 1) {
    pg8::Gemm g; g.A = A; g.Bt = Bt; g.M = M; g.N = N; g.K = K; g.ld = ld ? ld : K; g.ksplit = ksplit;
    pg8::StaticOrder S; S.init(M, N * ksplit, (int)gridDim.x, (int)blockIdx.x);
    pg8::gemm_phase<Epi>((LAS unsigned char*)shm, g, S, E);
    __syncthreads();
}

DI void transpose_item(const float* W, int K, int N, bf16_t* WT, float* scr, int item, int lane) {
    const int nblk = N / 32, kb = item / nblk, nb = item % nblk, k0 = 64 * kb, n0 = 32 * nb;
#pragma unroll 8
    for (int i = 0; i < 32; ++i) { const int kk = 2 * i + (lane >> 5); scr[kk * 33 + (lane & 31)] = W[(size_t)(k0 + kk) * N + n0 + (lane & 31)]; }
    asm volatile("s_waitcnt lgkmcnt(0)" ::: "memory");
    const int c = lane & 7;
#pragma unroll
    for (int j = 0; j < 4; ++j) { const int n = (lane >> 3) + 8 * j; const float* s = scr + (8 * c) * 33 + n;
        u32x4 o; o.x = pk2(s[0 * 33], s[1 * 33]); o.y = pk2(s[2 * 33], s[3 * 33]); o.z = pk2(s[4 * 33], s[5 * 33]); o.w = pk2(s[6 * 33], s[7 * 33]);
        *(u32x4*)(WT + (size_t)(n0 + n) * K + k0 + 8 * c) = o; }
    asm volatile("s_waitcnt lgkmcnt(0)" ::: "memory");
}

DI void phase0(const P& p, unsigned char* shm) {
    const int tid = otid(), lane = tid & 63, wid = tid >> 6;
    unsigned char* ws = p.ws;
    {
        float* scr = (float*)shm + wid * (64 * 33);
        const int gw = blockIdx.x * 8 + wid, NGW = gridDim.x * 8;
        constexpr int I_IN = 16 * 96, I_HO = 16 * 32, I_1 = 16 * 128, I_2 = 64 * 32, I_QKV = 16 * 48, I_AO = 16 * 32;
        constexpr int NITEMS = I_IN + I_HO + 2 * I_1 + 2 * I_2 + I_QKV + I_AO;
        for (int it = gw; it < NITEMS; it += NGW) {
            int r = it;
            if (r < I_IN) { transpose_item(p.hy_w_in, DM, 3 * DM, (bf16_t*)(ws + OFF_WIN), scr, r, lane); continue; } r -= I_IN;
            if (r < I_HO) { transpose_item(p.hy_w_out, DM, DM, (bf16_t*)(ws + OFF_WHO), scr, r, lane); continue; } r -= I_HO;
            if (r < 2 * I_1) { const int l = r / I_1; transpose_item(p.mlp_w1 + (size_t)l * DM * DFF, DM, DFF, (bf16_t*)(ws + OFF_W1) + (size_t)l * DM * DFF, scr, r % I_1, lane); continue; } r -= 2 * I_1;
            if (r < 2 * I_2) { const int l = r / I_2; transpose_item(p.mlp_w2 + (size_t)l * DM * DFF, DFF, DM, (bf16_t*)(ws + OFF_W2) + (size_t)l * DM * DFF, scr, r % I_2, lane); continue; } r -= 2 * I_2;
            if (r < I_QKV) { transpose_item(p.at_w_qkv, DM, 1536, (bf16_t*)(ws + OFF_WQKV), scr, r, lane); continue; } r -= I_QKV;
            transpose_item(p.at_w_out, DM, DM, (bf16_t*)(ws + OFF_WAO), scr, r, lane);
        }
    }
    __syncthreads();
    {
        float* sv = (float*)shm;
        float* part = sv + 9 * 1024;
        float* modv = (float*)(ws + OFF_MOD);
        bool filled = false;
        for (int it = blockIdx.x; it < 2 * 96; it += gridDim.x) {
            if (!filled) {
                for (int i = tid; i < 9 * 1024; i += 512) { const float v = (i < 8192) ? p.c[i] : p.c_ctx[i - 8192]; sv[i] = v / (1.f + __expf(-v)); }
                filled = true;
            }
            __syncthreads();
            const int l = it / 96, n0 = (it % 96) * 64;
            const float* w = p.mod_w + (size_t)l * DM * 6144 + n0 + lane;
            float acc[9];
#pragma unroll
            for (int bb = 0; bb < 9; ++bb) acc[bb] = 0.f;
            const int kb = wid * 128;
#pragma unroll 4
            for (int k = 0; k < 128; ++k) { const float wv = w[(size_t)(kb + k) * 6144];
#pragma unroll
                for (int bb = 0; bb < 9; ++bb) acc[bb] += sv[bb * 1024 + kb + k] * wv; }
#pragma unroll
            for (int bb = 0; bb < 9; ++bb) part[(wid * 9 + bb) * 64 + lane] = acc[bb];
            __syncthreads();
            for (int o = tid; o < 9 * 64; o += 512) { const int bb = o >> 6, n = o & 63; float s = p.mod_b[l * 6144 + n0 + n];
#pragma unroll
                for (int w8 = 0; w8 < 8; ++w8) s += part[(w8 * 9 + bb) * 64 + n];
                modv[(l * 9 + bb) * 6144 + n0 + n] = s; }
        }
    }
    __syncthreads();
    {
        float* zs = (float*)shm;
        float* h1 = zs + 8 * 40;
        const int tl = tid >> 6, j = lane;
        for (int it = blockIdx.x; it < 1024 + 32; it += gridDim.x) {
            const bool cx = it >= 1024; const int Ls = cx ? CL : SEQ; const int pos = (cx ? (it - 1024) : it) * 8 + tl;
            __syncthreads();
            if (j < 33) { float zv;
                if (j == 0) zv = (float)pos / (float)Ls;
                else { const int bi = (j - 1) & 15; const float band = 1e-4f + (float)bi * ((15.f - 1e-4f) / 15.f); const float turns = (float)pos * band / (float)Ls;
                    zv = (j <= 16) ? __builtin_amdgcn_cosf(turns) : -__builtin_amdgcn_sinf(turns); }
                zs[tl * 40 + j] = zv; }
            __syncthreads();
            { float a = p.hy_f_b1[j];
#pragma unroll 3
                for (int i = 0; i < 33; ++i) a += zs[tl * 40 + i] * p.hy_f_w1[i * 64 + j];
                h1[tl * 64 + j] = __sinf(p.hy_f_fr1[j] * a); }
            __syncthreads();
            { float a = p.hy_f_b2[j];
#pragma unroll 4
                for (int k = 0; k < 64; ++k) a += h1[tl * 64 + k] * p.hy_f_w2[k * 64 + j];
                float* H = (float*)(ws + (cx ? OFF_H2C : OFF_H2));
                H[(size_t)pos * 64 + j] = __sinf(p.hy_f_fr2[j] * a); }
        }
    }
    __syncthreads();
}

DI void kcgen_phase(const P& p, unsigned char* shm) {
    const int tid = otid(); const int lane = tid & 63, wid = __builtin_amdgcn_readfirstlane(tid >> 6);
    unsigned char* ws = p.ws;
    float* w3s = (float*)shm;
    const float* __restrict__ w3 = p.hy_f_w3;
    for (int it = blockIdx.x; it < 256; it += gridDim.x) {
        const int cc = it & 15, tg = it >> 4;
        __syncthreads();
        { const int k = tid >> 3, ci8 = (tid & 7) * 8;
#pragma unroll
            for (int dir = 0; dir < 2; ++dir) { const float* src = w3 + (size_t)k * 2048 + dir * 1024 + cc * 64 + ci8;
                const f32x4 v0 = *(const f32x4*)src, v1 = *(const f32x4*)(src + 4);
                float* d = w3s + (dir * 64 + ci8) * 64 + k;
                d[0] = v0.x; d[64] = v0.y; d[128] = v0.z; d[192] = v0.w; d[256] = v1.x; d[320] = v1.y; d[384] = v1.z; d[448] = v1.w; } }
        __syncthreads();
#pragma unroll 1
        for (int part = 0; part < 2; ++part) {
            const bool cx = part == 1; const int Ls = cx ? CL : SEQ;
            if (cx && wid >= 4) break;
            const int t = (cx ? wid : tg * 8 + wid) * 64 + lane;
            const float* H = (const float*)(ws + (cx ? OFF_H2C : OFF_H2)) + (size_t)t * 64;
            float h[64];
#pragma unroll
            for (int k = 0; k < 16; ++k) { const f32x4 v = *(const f32x4*)(H + 4 * k); h[4 * k] = v.x; h[4 * k + 1] = v.y; h[4 * k + 2] = v.z; h[4 * k + 3] = v.w; }
            float* kc = (float*)(ws + (cx ? OFF_KCUC : OFF_KCU));
            float* nrm = (float*)(ws + OFF_NORM) + (cx ? 1024 : 0);
            const float tf = (float)t / (float)Ls;
            const int ci_lo = cx ? 4 * tg : 0, ci_hi = cx ? 4 * tg + 4 : 64;
#pragma unroll 1
            for (int ci = ci_lo; ci < ci_hi; ++ci) {
                const int c = cc * 64 + ci;
                float af = 0.f, ab = 0.f;
#pragma unroll
                for (int k4 = 0; k4 < 16; ++k4) { const f32x4 wf = *(const f32x4*)(w3s + ci * 64 + 4 * k4), wb = *(const f32x4*)(w3s + (64 + ci) * 64 + 4 * k4);
                    af += h[4 * k4] * wf.x; af += h[4 * k4 + 1] * wf.y; af += h[4 * k4 + 2] * wf.z; af += h[4 * k4 + 3] * wf.w;
                    ab += h[4 * k4] * wb.x; ab += h[4 * k4 + 1] * wb.y; ab += h[4 * k4 + 2] * wb.z; ab += h[4 * k4 + 3] * wb.w; }
                const float delta = fabsf(-3.0701134573253945f + (float)c * ((-15.350567286626973f + 3.0701134573253945f) / 1023.f));
                const float dec = __expf(-tf * delta);
                const float vf = af * dec, vb = ab * dec;
                float* row = kc + (size_t)c * (2 * Ls);
                row[t] = vf;
                if (t >= 1) row[2 * Ls - t] = vb; else row[Ls] = 0.f;
                float sabs = fabsf(vf) + (t >= 1 ? fabsf(vb) : 0.f);
                sabs = wave_sum(sabs);
                if (lane == 0) atomicAdd(nrm + c, sabs);
            }
        }
    }
    __syncthreads();
}

DI void sw_phase(const P& p, unsigned char* shm) {
    const int tid = otid(), lane = tid & 63, wid = tid >> 6;
    unsigned char* ws = p.ws;
    float* sv = (float*)shm;
    float* part = sv + 9 * 1024;
    const float* modv = (const float*)(ws + OFF_MOD);
    for (int it = blockIdx.x; it < 64 + 24 + 64; it += gridDim.x) {
        int j, n0, ldw; const float* W; const float* shv;
        if (it < 64) { j = 0; n0 = it * 64; ldw = DFF; W = p.mlp_w1; shv = modv + 3 * 1024; }
        else if (it < 88) { j = 1; n0 = (it - 64) * 64; ldw = 1536; W = p.at_w_qkv; shv = modv + 9 * 6144; }
        else { j = 2; n0 = (it - 88) * 64; ldw = DFF; W = p.mlp_w1 + (size_t)DM * DFF; shv = modv + 9 * 6144 + 3 * 1024; }
        __syncthreads();
        for (int i = tid; i < 9 * 1024; i += 512) sv[i] = shv[(i >> 10) * 6144 + (i & 1023)];
        __syncthreads();
        const float* w = W + n0 + lane;
        float acc[9];
#pragma unroll
        for (int bb = 0; bb < 9; ++bb) acc[bb] = 0.f;
        const int kb = wid * 128;
#pragma unroll 4
        for (int k = 0; k < 128; ++k) { const float wv = w[(size_t)(kb + k) * ldw];
#pragma unroll
            for (int bb = 0; bb < 9; ++bb) acc[bb] += sv[bb * 1024 + kb + k] * wv; }
#pragma unroll
        for (int bb = 0; bb < 9; ++bb) part[(wid * 9 + bb) * 64 + lane] = acc[bb];
        __syncthreads();
        float* sw = (float*)(ws + OFF_SW) + j * 9 * 4096;
        for (int o = tid; o < 9 * 64; o += 512) { const int bb = o >> 6, n = o & 63; float a = 0.f;
#pragma unroll
            for (int w8 = 0; w8 < 8; ++w8) a += part[(w8 * 9 + bb) * 64 + n];
            sw[bb * 4096 + n0 + n] = a; }
    }
    __syncthreads();
}

DI void rnorm_phase(const float* part, float* r, int nrows) {
    const int tid = otid();
    for (int row = blockIdx.x * 512 + tid; row < nrows; row += gridDim.x * 512) {
        const f32x4* q = (const f32x4*)(part + (size_t)row * 16);
        const f32x4 a = q[0], b = q[1], c = q[2], d = q[3];
        const float ssum = ((a.x + a.y) + (a.z + a.w)) + ((b.x + b.y) + (b.z + b.w)) + ((c.x + c.y) + (c.z + c.w)) + ((d.x + d.y) + (d.z + d.w));
        r[row] = __builtin_amdgcn_rsqf(ssum * (1.f / DM) + EPS);
    }
}

DI void ctx_finalize(const float* part, int ksplit, const float* srcf  , const float* bias, bf16_t* cxb, const float* gate8, const float* gw, const float* scl8, bf16_t* xgc, float* rc) {
    const int tid = otid(); const int lane = tid & 63, wid = tid >> 6;
    for (int row = blockIdx.x * 8 + wid; row < TC; row += gridDim.x * 8) {
        f32x4 a[4];
#pragma unroll
        for (int j = 0; j < 4; ++j) a[j] = (f32x4){0.f, 0.f, 0.f, 0.f};
        for (int ks = 0; ks < ksplit; ++ks) { const float* pr = part + ((size_t)ks * TC + row) * DM + 4 * lane;
#pragma unroll
            for (int j = 0; j < 4; ++j) a[j] += *(const f32x4*)(pr + 256 * j); }
        float ss = 0.f; f32x4 o[4];
#pragma unroll
        for (int j = 0; j < 4; ++j) { const int c = 4 * lane + 256 * j; f32x4 sv;
            if (srcf) sv = *(const f32x4*)(srcf + (size_t)row * DM + c);
            else { const u32x2 w = *(const u32x2*)(cxb + (size_t)row * DM + c); sv = (f32x4){bf_lo(w.x), bf_hi(w.x), bf_lo(w.y), bf_hi(w.y)}; }
            if (bias) a[j] += *(const f32x4*)(bias + c);
            o[j] = sv + *(const f32x4*)(gate8 + c) * a[j];
            ss += (o[j].x * o[j].x + o[j].y * o[j].y) + (o[j].z * o[j].z + o[j].w * o[j].w); }
        ss = wave_sum(ss);
        if (lane == 0) rc[row] = __builtin_amdgcn_rsqf(ss * (1.f / DM) + EPS);
#pragma unroll
        for (int j = 0; j < 4; ++j) { const int c = 4 * lane + 256 * j;
            u32x2 w; w.x = pk2(o[j].x, o[j].y); w.y = pk2(o[j].z, o[j].w); *(u32x2*)(cxb + (size_t)row * DM + c) = w;
            const f32x4 t = o[j] * (*(const f32x4*)(gw + c)) * (*(const f32x4*)(scl8 + c) + 1.f);
            u32x2 x; x.x = pk2(t.x, t.y); x.y = pk2(t.z, t.w); *(u32x2*)(xgc + (size_t)row * DM + c) = x; }
    }
}

DI void norm_phase(const float* srcX, const float* srcC, const float* g, const float* modl  , int shift_chunk, int scale_chunk, bf16_t* hbuf, int nrows, unsigned char* shm) {
    const int tid = otid(); const int lane = tid & 63, wid = tid >> 6;
    const int gw = blockIdx.x * 8 + wid, NGW = gridDim.x * 8;
    f32x4 gv[4];
#pragma unroll
    for (int j = 0; j < 4; ++j) gv[j] = *(const f32x4*)(g + 4 * lane + 256 * j);
    float* shs = (float*)shm; float* scs = shs + 9 * 1024;
    __syncthreads();
    for (int i = tid; i < 9 * 1024; i += 512) { const int mi = i >> 10, c = i & 1023; shs[i] = modl[mi * 6144 + shift_chunk * 1024 + c]; scs[i] = modl[mi * 6144 + scale_chunk * 1024 + c]; }
    __syncthreads();
    for (int row0 = gw; row0 < nrows; row0 += 2 * NGW) {
        f32x4 v[2][4];
#pragma unroll
        for (int rr = 0; rr < 2; ++rr) { const int row = row0 + rr * NGW; const bool lat = row < TX;
            const float* xr = lat ? srcX + (size_t)row * DM : srcC + (size_t)(row - TX) * DM;
#pragma unroll
            for (int j = 0; j < 4; ++j) v[rr][j] = (row < nrows) ? *(const f32x4*)(xr + 4 * lane + 256 * j) : (f32x4){0.f, 0.f, 0.f, 0.f}; }
#pragma unroll
        for (int rr = 0; rr < 2; ++rr) { const int row = row0 + rr * NGW; const bool lat = row < TX; const int mi = lat ? (row >> 13) : 8;
            float ss = 0.f;
#pragma unroll
            for (int j = 0; j < 4; ++j) ss += (v[rr][j].x * v[rr][j].x + v[rr][j].y * v[rr][j].y) + (v[rr][j].z * v[rr][j].z + v[rr][j].w * v[rr][j].w);
            ss = wave_sum(ss);
            const float r = __builtin_amdgcn_rsqf(ss * (1.f / DM) + EPS);
            const float* sh = shs + mi * 1024; const float* sc = scs + mi * 1024;
            if (row < nrows) { bf16_t* orow = hbuf + (size_t)row * DM;
#pragma unroll
                for (int j = 0; j < 4; ++j) { const f32x4 s4 = *(const f32x4*)(sh + 4 * lane + 256 * j), c1 = *(const f32x4*)(sc + 4 * lane + 256 * j);
                    const f32x4 y = v[rr][j] * r * gv[j] * (c1 + 1.f) + s4;
                    u32x2 w; w.x = pk2(y.x, y.y); w.y = pk2(y.z, y.w);
                    *(u32x2*)(orow + 4 * lane + 256 * j) = w; } }
        }
    }
}

DI void conv_item_coords(int item, int& b, int& tt, int& ct, int& rowb, int& Ls) {
    if (item < 16384) { ct = item & 15; tt = (item >> 4) & 127; b = item >> 11; rowb = b * SEQ; Ls = SEQ; }
    else { const int j = item - 16384; ct = j & 15; tt = (j >> 4) & 3; b = j >> 6; rowb = TX + b * CL; Ls = CL; }
}
DI void conv8(const bf16_t* seq, int t0, int Ls, float w0, float w1, float w2, float cb, float (&o)[8]) {
    float xm[8]; unpack8(*(const u32x4*)(seq + t0), xm);
    const float xl = (t0 > 0) ? bf1(seq[t0 - 1]) : 0.f, xr = (t0 + 8 < Ls) ? bf1(seq[t0 + 8]) : 0.f;
    o[0] = cb + w0 * xl + w1 * xm[0] + w2 * xm[1];
#pragma unroll
    for (int e = 1; e < 7; ++e) o[e] = cb + w0 * xm[e - 1] + w1 * xm[e] + w2 * xm[e + 1];
    o[7] = cb + w0 * xm[6] + w1 * xm[7] + w2 * xr;
}
struct ZIn { u32x4 x, y; float xl, xr, w0, w1, w2, cb; };
DI void zback_load(const P& p, int item, int tid, ZIn& z) {
    int b, tt, ct, rowb, Ls; conv_item_coords(item, b, tt, ct, rowb, Ls);
    const int cl = tid >> 3, t8 = (tid & 7) * 8, c = ct * 64 + cl, t0 = tt * 64 + t8;
    const bf16_t* seq = (const bf16_t*)(p.ws + OFF_BIG) + (size_t)c * TT + rowb;
    z.x = *(const u32x4*)(seq + t0);
    z.xl = (t0 > 0) ? bf1(seq[t0 - 1]) : 0.f; z.xr = (t0 + 8 < Ls) ? bf1(seq[t0 + 8]) : 0.f;
    z.y = *(const u32x4*)((Ls == SEQ) ? (const bf16_t*)(p.ws + OFF_UT) + ((size_t)(b * DM + c)) * SEQ + t0 : (const bf16_t*)(p.ws + OFF_UTC) + ((size_t)(b * DM + c)) * CL + t0);
    z.w0 = p.hy_conv_w[c]; z.w1 = p.hy_conv_w[3072 + c]; z.w2 = p.hy_conv_w[6144 + c]; z.cb = p.hy_conv_b[c];
}
DI void zback_phase(const P& p, unsigned char* shm) {
    const int tid = otid();
    bf16_t* hbuf = (bf16_t*)(p.ws + OFF_HBUF);
    bf16_t* zs = (bf16_t*)shm;
    constexpr int NIT = 16384 + 512;
    ZIn cur, nxt, nx2;
    int item = blockIdx.x;
    if (item < NIT) zback_load(p, item, tid, cur);
    if (item + (int)gridDim.x < NIT) zback_load(p, item + gridDim.x, tid, nxt); else nxt = cur;
    for (; item < NIT; item += gridDim.x) {
        const int nitem = item + 2 * gridDim.x;
        if (nitem < NIT) zback_load(p, nitem, tid, nx2); else nx2 = nxt;
        int b, tt, ct, rowb, Ls; conv_item_coords(item, b, tt, ct, rowb, Ls);
        { const int cl = tid >> 3, t8 = (tid & 7) * 8;
            float xm[8], yv[8], o[8]; unpack8(cur.x, xm); unpack8(cur.y, yv);
            o[0] = cur.cb + cur.w0 * cur.xl + cur.w1 * xm[0] + cur.w2 * xm[1];
#pragma unroll
            for (int e = 1; e < 7; ++e) o[e] = cur.cb + cur.w0 * xm[e - 1] + cur.w1 * xm[e] + cur.w2 * xm[e + 1];
            o[7] = cur.cb + cur.w0 * xm[6] + cur.w1 * xm[7] + cur.w2 * cur.xr;
#pragma unroll
            for (int e = 0; e < 8; ++e) o[e] *= yv[e];
            __syncthreads();
            *(u32x4*)(zs + cl * 72 + t8) = pack8(o); }
        __syncthreads();
        { const int tl = tid >> 3, c8 = (tid & 7) * 8;
            float z[8];
#pragma unroll
            for (int e = 0; e < 8; ++e) z[e] = bf1(zs[(c8 + e) * 72 + tl]);
            *(u32x4*)(hbuf + (size_t)(rowb + tt * 64 + tl) * DM + ct * 64 + c8) = pack8(z); }
        cur = nxt; nxt = nx2;
    }
    __syncthreads();
}

constexpr float C16[8] = {1.f, 0.92387953251128674f, 0.70710678118654752f, 0.38268343236508977f, 0.f, -0.38268343236508977f, -0.70710678118654752f, -0.92387953251128674f};
constexpr float S16[8] = {0.f, 0.38268343236508977f, 0.70710678118654752f, 0.92387953251128674f, 1.f, 0.92387953251128674f, 0.70710678118654752f, 0.38268343236508977f};
DI f2_t cmul(f2_t a, f2_t w) { return (f2_t){a.x, a.x} * w + (f2_t){a.y, a.y} * (f2_t){-w.y, w.x}; }
DI f2_t cmulc(f2_t a, f2_t w) { return (f2_t){a.x, a.x} * (f2_t){w.x, -w.y} + (f2_t){a.y, a.y} * (f2_t){w.y, w.x}; }
DI f2_t mul_mi(f2_t a) { return (f2_t){a.y, -a.x}; }
DI f2_t mul_pi(f2_t a) { return (f2_t){-a.y, a.x}; }
template <int R, int LEN, bool INV> DI void dif_stages(f2_t (&x)[R]) {
    constexpr int half = LEN / 2, ts = 16 / LEN;
#pragma unroll
    for (int blk = 0; blk < R; blk += LEN)
#pragma unroll
        for (int j = 0; j < half; ++j) {
            const int i0 = blk + j, i1 = i0 + half;
            const f2_t a = x[i0], b = x[i1];
            x[i0] = a + b;
            const f2_t t = a - b;
            const int k = j * ts;
            if (k == 0) x[i1] = t;
            else if (k == 4) x[i1] = INV ? mul_pi(t) : mul_mi(t);
            else { const f2_t w = {C16[k], S16[k]}; x[i1] = INV ? cmul(t, w) : cmulc(t, w); }
        }
    if constexpr (LEN > 2) dif_stages<R, LEN / 2, INV>(x);
}
template <int R> DI constexpr int brev(int p) { int r = 0; for (int i = 0, b = (R == 8 ? 3 : 4); i < b; ++i) r |= ((p >> i) & 1) << (b - 1 - i); return r; }

template <int PASS, bool INV> DI void bfly_addr(int q, int& a0, int& astr, int& np) {
    if (PASS == 1) { a0 = (q >> 7) * 129 + (q & 127); astr = 16 * 129; np = q; }
    else if (PASS == 2) { a0 = (q >> 7) * 16 * 129 + (q & 127); astr = 129; np = q & 127; }
    else if (PASS == 3) { a0 = (q & 127) * 129 + (q >> 7); astr = 16; np = q >> 7; }
    else { a0 = (q & 127) * 129 + (q >> 7) * 16; astr = 1; np = 0; }
    if (PASS != 4) asm volatile("" : "+v"(np));
}
template <int R> DI void tw_powers(f2_t w1, f2_t (&pw)[R]) {
    pw[1] = w1;
#pragma unroll
    for (int k = 2; k < R; ++k) { const int hb = (k >= 8) ? 8 : (k >= 4) ? 4 : 2; const int lo = k - hb;
        if (lo == 0) pw[k] = cmul(pw[hb / 2], pw[hb / 2]); else pw[k] = cmul(pw[hb], pw[lo]); }
}
template <int PASS, bool INV, int MODE, int R> DI void bfly_compute(f2_t (&x)[R], int np) {
    constexpr float invM = (PASS == 1) ? (1.f / 16384.f) : (PASS == 2) ? (1.f / 2048.f) : (1.f / 128.f);
    f2_t pw[R];
    if (PASS != 4) { const float turns = (float)np * invM; f2_t w1 = {__builtin_amdgcn_cosf(turns), __builtin_amdgcn_sinf(turns)}; if (!INV) w1.y = -w1.y; tw_powers<R>(w1, pw); }
    if (INV && PASS != 4) {
#pragma unroll
        for (int k = 1; k < R; ++k) x[k] = cmul(x[k], pw[k]);
    }
    if (MODE == 1) {
        x[4] = x[0]; x[5] = cmulc(x[1], (f2_t){S16[2], S16[2]}); x[6] = mul_mi(x[2]); x[7] = cmulc(x[3], (f2_t){-S16[2], S16[2]});
        dif_stages<R, 4, INV>(x);
    } else dif_stages<R, R, INV>(x);
    if (!INV && PASS != 4) {
#pragma unroll
        for (int k = 1; k < R; ++k) { const int pp = brev<R>(k); x[pp] = cmul(x[pp], pw[k]); }
    }
}
template <int PASS, bool INV, int MODE> DI void fft_pass(f2_t* lds, int tid, const f2_t* kmul, f2_t* kout, float sc) {
    constexpr int R = (PASS == 1 || PASS == 3) ? 8 : 16;
    constexpr int NBF = 16384 / R;
    constexpr int RL = (MODE == 1) ? R / 2 : R;
#pragma unroll 1
    for (int q = tid; q < NBF; q += 1024) {
        int a0A, asA, npA, a0B, asB, npB;
        bfly_addr<PASS, INV>(q, a0A, asA, npA); bfly_addr<PASS, INV>(q + 512, a0B, asB, npB);
        f2_t xA[R], xB[R];
#pragma unroll
        for (int n = 0; n < RL; ++n) { xA[n] = lds[a0A + n * asA]; xB[n] = lds[a0B + n * asB]; }
        bfly_compute<PASS, INV, MODE, R>(xA, npA);
        bfly_compute<PASS, INV, MODE, R>(xB, npB);
#pragma unroll
        for (int pp = 0; pp < R; ++pp) {
            if (MODE == 4 && (pp & 1)) continue;
            const int aA = a0A + brev<R>(pp) * asA, aB = a0B + brev<R>(pp) * asB;
            f2_t v = xA[pp], w = xB[pp];
            if (MODE == 2) { v = cmul(v, kmul[aA]); w = cmul(w, kmul[aB]); }
            if (MODE == 3) { v = v * sc; w = w * sc; kout[aA] = v; kout[aB] = w; }
            else { lds[aA] = v; lds[aB] = w; }
        }
    }
    __syncthreads();
}

DI void fftconv_phase(const P& p, unsigned char* shm) {
    const int tid = otid(), lane = tid & 63, wid = tid >> 6;
    unsigned char* ws = p.ws;
    f2_t* lds = (f2_t*)shm;
    f2_t* kscr2 = (f2_t*)(ws + OFF_HBUF) + (size_t)blockIdx.x * (2 * 16512);
    const float* nrm = (const float*)(ws + OFF_NORM);
    for (int cpair = blockIdx.x; cpair < DM; cpair += 2 * gridDim.x)
    for (int which = 0; which < 2; ++which) {
        const int c = cpair + which * gridDim.x;
        if (c >= DM) break;
        f2_t* kscr = kscr2 + which * 16512;
        if (which == 0) {
            const int cB = cpair + gridDim.x; const bool hasB = cB < DM;
            __syncthreads();
            { const float* kcA = (const float*)(ws + OFF_KCU) + (size_t)cpair * 16384; const float* kcB = (const float*)(ws + OFF_KCU) + (size_t)(hasB ? cB : cpair) * 16384;
#pragma unroll 4
                for (int i = tid * 4; i < 16384; i += 2048) { const f32x4 v = *(const f32x4*)(kcA + i); f32x4 w = *(const f32x4*)(kcB + i); if (!hasB) w = (f32x4){0.f, 0.f, 0.f, 0.f};
                    const int a = (i >> 7) * 129 + (i & 127);
                    lds[a] = (f2_t){v.x, w.x}; lds[a + 1] = (f2_t){v.y, w.y}; lds[a + 2] = (f2_t){v.z, w.z}; lds[a + 3] = (f2_t){v.w, w.w}; } }
            __syncthreads();
            fft_pass<1, false, 0>(lds, tid, nullptr, nullptr, 0.f); fft_pass<2, false, 0>(lds, tid, nullptr, nullptr, 0.f); fft_pass<3, false, 0>(lds, tid, nullptr, nullptr, 0.f);
            fft_pass<4, false, 0>(lds, tid, nullptr, nullptr, 0.f);
            { const float sA = 0.5f / (16384.f * nrm[cpair]), sB = 0.5f / (16384.f * nrm[hasB ? cB : cpair]);
#pragma unroll 4
                for (int pq = tid; pq < 16384; pq += 512) {
                    const int k = (pq >> 11) + (((pq >> 7) & 15) << 3) + (((pq >> 4) & 7) << 7) + ((pq & 15) << 10);
                    const int kn = (16384 - k) & 16383;
                    const int pn = ((kn & 7) << 11) + (((kn >> 3) & 15) << 7) + (((kn >> 7) & 7) << 4) + (kn >> 10);
                    const int a = (pq >> 7) * 129 + (pq & 127), an = (pn >> 7) * 129 + (pn & 127);
                    const f2_t z = lds[a], zn = lds[an];
                    kscr2[a] = (f2_t){(z.x + zn.x) * sA, (z.y - zn.y) * sA};
                    kscr2[16512 + a] = (f2_t){(z.y + zn.y) * sB, (zn.x - z.x) * sB}; } }
        }
        const float skip = p.hy_skip[c];
        const bf16_t* x1r = (const bf16_t*)(ws + OFF_BIG) + (size_t)(DM + c) * TT; const bf16_t* vr = (const bf16_t*)(ws + OFF_BIG) + (size_t)(2 * DM + c) * TT;
        const float wx0 = p.hy_conv_w[DM + c], wx1 = p.hy_conv_w[3072 + DM + c], wx2 = p.hy_conv_w[6144 + DM + c], cbx = p.hy_conv_b[DM + c];
        const float wv0 = p.hy_conv_w[2 * DM + c], wv1 = p.hy_conv_w[3072 + 2 * DM + c], wv2 = p.hy_conv_w[6144 + 2 * DM + c], cbv = p.hy_conv_b[2 * DM + c];
#pragma unroll 1
        for (int bp = 0; bp < 4; ++bp) {
            bf16_t* u0 = (bf16_t*)(ws + OFF_UT) + ((size_t)((2 * bp) * DM + c)) * SEQ;
            bf16_t* u1 = u0 + (size_t)DM * SEQ;
            const bf16_t* sx = x1r + (2 * bp) * SEQ; const bf16_t* sv = vr + (2 * bp) * SEQ;
            __syncthreads();
#pragma unroll
            for (int jj = 0; jj < 2; ++jj) { const int t0 = (tid + 512 * jj) * 8;
                float a[8], b[8], a2[8], b2[8];
                conv8(sx, t0, SEQ, wx0, wx1, wx2, cbx, a); conv8(sv, t0, SEQ, wv0, wv1, wv2, cbv, a2);
                conv8(sx + SEQ, t0, SEQ, wx0, wx1, wx2, cbx, b); conv8(sv + SEQ, t0, SEQ, wv0, wv1, wv2, cbv, b2);
                const int ad = (t0 >> 7) * 129 + (t0 & 127);
#pragma unroll
                for (int e = 0; e < 8; ++e) lds[ad + e] = (f2_t){a[e] * a2[e], b[e] * b2[e]}; }
            __syncthreads();
            fft_pass<1, false, 1>(lds, tid, nullptr, nullptr, 0.f); fft_pass<2, false, 0>(lds, tid, nullptr, nullptr, 0.f); fft_pass<3, false, 0>(lds, tid, nullptr, nullptr, 0.f);
            fft_pass<4, false, 2>(lds, tid, kscr, nullptr, 0.f);
            fft_pass<4, true, 0>(lds, tid, nullptr, nullptr, 0.f); fft_pass<3, true, 0>(lds, tid, nullptr, nullptr, 0.f); fft_pass<2, true, 0>(lds, tid, nullptr, nullptr, 0.f);
            fft_pass<1, true, 4>(lds, tid, nullptr, nullptr, 0.f);
#pragma unroll
            for (int jj = 0; jj < 2; ++jj) { const int t0 = (tid + 512 * jj) * 8;
                float a[8], b[8], a2[8], b2[8];
                conv8(sx, t0, SEQ, wx0, wx1, wx2, cbx, a); conv8(sv, t0, SEQ, wv0, wv1, wv2, cbv, a2);
                conv8(sx + SEQ, t0, SEQ, wx0, wx1, wx2, cbx, b); conv8(sv + SEQ, t0, SEQ, wv0, wv1, wv2, cbv, b2);
                const int ad = (t0 >> 7) * 129 + (t0 & 127);
#pragma unroll
                for (int e = 0; e < 8; ++e) { const f2_t v = lds[ad + e]; a[e] = v.x + a[e] * a2[e] * skip; b[e] = v.y + b[e] * b2[e] * skip; }
                *(u32x4*)(u0 + t0) = pack8(a); *(u32x4*)(u1 + t0) = pack8(b); }
        }
        __syncthreads();
        {
            float* kcs = (float*)shm; float* usm = kcs + 512;
            const float* kcc = (const float*)(ws + OFF_KCUC) + (size_t)c * 512;
            const float inrm = 1.f / nrm[1024 + c];
            for (int i = tid; i < 512; i += 512) kcs[i] = kcc[i] * inrm;
            bf16_t* utc = (bf16_t*)(ws + OFF_UTC);
#pragma unroll
            for (int i = tid; i < 2048; i += 512) { const int b = i >> 8, t = i & 255; const bf16_t* qx = x1r + TX + b * CL; const bf16_t* qv = vr + TX + b * CL;
                const float xl = t > 0 ? bf1(qx[t - 1]) : 0.f, xr = t < CL - 1 ? bf1(qx[t + 1]) : 0.f, vl = t > 0 ? bf1(qv[t - 1]) : 0.f, vrr = t < CL - 1 ? bf1(qv[t + 1]) : 0.f;
                usm[i] = (cbx + wx0 * xl + wx1 * bf1(qx[t]) + wx2 * xr) * (cbv + wv0 * vl + wv1 * bf1(qv[t]) + wv2 * vrr); }
            __syncthreads();
            const int b = wid;
            float acc[4] = {0.f, 0.f, 0.f, 0.f};
            float ur[4];
#pragma unroll
            for (int k = 0; k < 4; ++k) ur[k] = usm[b * 256 + 64 * k + lane];
#pragma unroll 4
            for (int sl = 0; sl < 64; ++sl) {
                float kv[7];
#pragma unroll
                for (int d = 0; d < 7; ++d) kv[d] = kcs[(lane - sl + 64 * (d - 3)) & 511];
                float uk[4];
#pragma unroll
                for (int k = 0; k < 4; ++k) uk[k] = __builtin_bit_cast(float, __builtin_amdgcn_readlane(__builtin_bit_cast(int, ur[k]), sl));
#pragma unroll
                for (int jj = 0; jj < 4; ++jj)
#pragma unroll
                    for (int k = 0; k < 4; ++k) acc[jj] += uk[k] * kv[jj - k + 3];
            }
#pragma unroll
            for (int jj = 0; jj < 4; ++jj) { const int t = lane + 64 * jj; utc[((size_t)(b * DM + c)) * CL + t] = f2bf(acc[jj] + usm[b * 256 + t] * skip); }
        }
    }
    __syncthreads();
}

DI void kprep_phase(const P& p) {
    const int tid = otid(); const int lane = tid & 63, wid = tid >> 6;
    const int gw = blockIdx.x * 8 + wid, NGW = gridDim.x * 8;
    bf16_t* qkv = (bf16_t*)(p.ws + OFF_BIG);
    const int j = lane & 7, hk = (lane >> 3) & 3, rsel = lane >> 5;
    float kn[8], inv[8];
#pragma unroll
    for (int e = 0; e < 8; ++e) { kn[e] = p.at_k_norm[8 * j + e];
        inv[e] = __builtin_amdgcn_exp2f(-(float)(8 * (j & 1) + e) * (13.287712379549449f / 16.f)) * 0.15915494309189535f; }
    const bool rowax = j < 4, hi = (j & 2) != 0;
    for (int it0 = gw; 2 * it0 < TT; it0 += 2 * NGW) {
        u32x4 w[2];
#pragma unroll
        for (int rr = 0; rr < 2; ++rr) { const int row = 2 * (it0 + rr * NGW) + rsel;
            w[rr] = (row < TT) ? *(const u32x4*)(qkv + (size_t)row * 1536 + 1024 + hk * 64 + 8 * j) : (u32x4){0u, 0u, 0u, 0u}; }
#pragma unroll
        for (int rr = 0; rr < 2; ++rr) { const int row = 2 * (it0 + rr * NGW) + rsel; const bool lat = row < TX;
            float x[8]; unpack8(w[rr], x);
            float ss = 0.f;
#pragma unroll
            for (int e = 0; e < 8; ++e) ss += x[e] * x[e];
            ss += dpp_mov<0xB1>(ss); ss += dpp_mov<0x4E>(ss); ss += dpp_mov<0x141>(ss);
            const float rs = __builtin_amdgcn_rsqf(ss * (1.f / 64.f) + EPS);
            const int t = row & (SEQ - 1); const float pos = (float)(rowax ? (t >> 6) : (t & 63));
#pragma unroll
            for (int e = 0; e < 8; ++e) { float y = x[e] * rs * kn[e];
                const float pr = dpp_mov<0x4E>(y);
                const float turns = pos * inv[e]; const float cs = __builtin_amdgcn_cosf(turns), sn = __builtin_amdgcn_sinf(turns);
                if (lat) y = hi ? (y * cs + pr * sn) : (y * cs - pr * sn);
                x[e] = y; }
            if (row < TT) *(u32x4*)(qkv + (size_t)row * 1536 + 1024 + hk * 64 + 8 * j) = pack8(x); }
    }
}

DI void attn_stage_load(const bf16_t* qkv, int rowk, int g, int tid, u32x4 (&kr)[2], u32x4 (&vr)[2]) {
    { const int key = tid >> 2, c4 = tid & 3; const bf16_t* src = qkv + (size_t)(rowk + key) * 1536 + 1024 + g * 64 + c4 * 16; kr[0] = *(const u32x4*)src; kr[1] = *(const u32x4*)(src + 8); }
    { const int key = tid & 127, dg = tid >> 7; const bf16_t* src = qkv + (size_t)(rowk + key) * 1536 + 1280 + g * 64 + dg * 8; vr[0] = *(const u32x4*)src; vr[1] = *(const u32x4*)(src + 32); }
}
DI void attn_stage_store(bf16_t* Ks, bf16_t* Vt, int tid, const u32x4 (&kr)[2], const u32x4 (&vr)[2]) {
    { const int key = tid >> 2, c4 = tid & 3; *(u32x4*)(Ks + key * 72 + c4 * 16) = kr[0]; *(u32x4*)(Ks + key * 72 + c4 * 16 + 8) = kr[1]; }
    { const int key = tid & 127, dg = tid >> 7;
#pragma unroll
        for (int hf = 0; hf < 2; ++hf) { const int d0 = hf * 32 + dg * 8; const u32x4 w = vr[hf];
            Vt[(d0 + 0) * 132 + key] = (bf16_t)(w.x & 0xffff); Vt[(d0 + 1) * 132 + key] = (bf16_t)(w.x >> 16);
            Vt[(d0 + 2) * 132 + key] = (bf16_t)(w.y & 0xffff); Vt[(d0 + 3) * 132 + key] = (bf16_t)(w.y >> 16);
            Vt[(d0 + 4) * 132 + key] = (bf16_t)(w.z & 0xffff); Vt[(d0 + 5) * 132 + key] = (bf16_t)(w.z >> 16);
            Vt[(d0 + 6) * 132 + key] = (bf16_t)(w.w & 0xffff); Vt[(d0 + 7) * 132 + key] = (bf16_t)(w.w >> 16); } }
}
DI void attn_phase(const P& p, unsigned char* shm) {
    const int tid = otid(), lane = tid & 63, wid = tid >> 6, r = lane & 31, h = lane >> 5;
    constexpr int BUFB = 18432 + 16896;
    const bf16_t* qkv = (const bf16_t*)(p.ws + OFF_BIG);
    bf16_t* obuf = (bf16_t*)(p.ws + OFF_HBUF);
    float mq = fabsf(p.at_q_norm[lane]), mk = fabsf(p.at_k_norm[lane]);
#pragma unroll
    for (int o = 1; o < 64; o <<= 1) { mq = fmaxf(mq, __shfl_xor(mq, o)); mk = fmaxf(mk, __shfl_xor(mk, o)); }
    const float negB = -(8.f * LOG2E) * mq * mk;
    for (int unit = blockIdx.x; unit < 2048; unit += gridDim.x) {
        const int qb = unit & 63, g = (unit >> 6) & 3, b = unit >> 8;
        const int q0 = qb * 128, hd = g * 4 + (wid >> 1), woff = (wid & 1) * 64, qs = q0 + woff;
        bf16x8 qf[2][4];
        int hq = h; asm volatile("" : "+v"(hq));
#pragma unroll
        for (int m = 0; m < 2; ++m) {
            const int t = qs + 32 * m + r;
            float x[4][8]; float ss = 0.f;
#pragma unroll
            for (int s = 0; s < 4; ++s) { unpack8(*(const u32x4*)(qkv + (size_t)(b * SEQ + t) * 1536 + hd * 64 + 16 * s + 8 * h), x[s]);
#pragma unroll
                for (int e = 0; e < 8; ++e) ss += x[s][e] * x[s][e]; }
            ss += __shfl_xor(ss, 32);
            const float rs = __builtin_amdgcn_rsqf(ss * (1.f / 64.f) + EPS);
            const float rsq = rs * (0.125f * LOG2E);
#pragma unroll
            for (int s = 0; s < 4; ++s) { const f32x4 g0 = *(const f32x4*)(p.at_q_norm + 16 * s + 8 * hq), g1 = *(const f32x4*)(p.at_q_norm + 16 * s + 8 * hq + 4);
                x[s][0] *= rsq * g0.x; x[s][1] *= rsq * g0.y; x[s][2] *= rsq * g0.z; x[s][3] *= rsq * g0.w; x[s][4] *= rsq * g1.x; x[s][5] *= rsq * g1.y; x[s][6] *= rsq * g1.z; x[s][7] *= rsq * g1.w; }
#pragma unroll
            for (int ax = 0; ax < 2; ++ax) { const float pos = (float)(ax == 0 ? (t >> 6) : (t & 63));
#pragma unroll
                for (int e = 0; e < 8; ++e) { const float turns = pos * (__builtin_amdgcn_exp2f(-(float)(8 * hq + e) * (13.287712379549449f / 16.f)) * 0.15915494309189535f); const float cs = __builtin_amdgcn_cosf(turns), sn = __builtin_amdgcn_sinf(turns);
                    const float x1 = x[2 * ax][e], x2 = x[2 * ax + 1][e];
                    x[2 * ax][e] = x1 * cs - x2 * sn; x[2 * ax + 1][e] = x2 * cs + x1 * sn; } }
#pragma unroll
            for (int s = 0; s < 4; ++s) qf[m][s] = __builtin_bit_cast(bf16x8, pack8(x[s]));
        }
        f32x16 o[2][2];
#pragma unroll
        for (int m = 0; m < 2; ++m)
#pragma unroll
            for (int d = 0; d < 2; ++d)
#pragma unroll
                for (int i = 0; i < 16; ++i) o[m][d][i] = 0.f;
        float lrun[2] = {0.f, 0.f};
        const int ch0 = (q0 == 0) ? 1 : 0;
        auto chunk_row = [&](int ch) { return (ch < 3) ? (b * SEQ + q0 - 128 + 128 * ch) : (TX + b * CL + (ch - 3) * 128); };
        auto chunk_next = [&](int ch) { int n = ch + 1; if (n == 2 && q0 + 128 >= SEQ) n = 3; return n; };
        u32x4 kr[2], vr[2];
        __syncthreads();
        attn_stage_load(qkv, chunk_row(ch0), g, tid, kr, vr);
        attn_stage_store((bf16_t*)shm, (bf16_t*)(shm + 18432), tid, kr, vr);
        __syncthreads();
        int buf = 0;
        for (int ch = ch0; ch < 5; ) {
            const int nch = chunk_next(ch);
            if (nch < 5) attn_stage_load(qkv, chunk_row(nch), g, tid, kr, vr);
            const bf16_t* Ks = (const bf16_t*)(shm + buf * BUFB); const bf16_t* Vt = (const bf16_t*)(shm + buf * BUFB + 18432);
#pragma unroll
            for (int m = 0; m < 2; ++m) {
                const int dk = (woff + 32 * m) >> 5;
                const int kt_lo = (ch == 0) ? dk : 0, kt_hi = (ch == 2) ? dk : 3;
                for (int kt = kt_lo; kt <= kt_hi; ++kt) {
                    f32x16 sa;
#pragma unroll
                    for (int i = 0; i < 16; ++i) sa[i] = negB;
#pragma unroll
                    for (int s = 0; s < 4; ++s) { const bf16x8 a = *(const bf16x8*)(Ks + (kt * 32 + r) * 72 + 16 * s + 8 * h); sa = __builtin_amdgcn_mfma_f32_32x32x16_bf16(a, qf[m][s], sa, 0, 0, 0); }
                    float psum = 0.f;
                    if ((ch == 0 || ch == 2) && kt == dk) {
#pragma unroll
                        for (int i = 0; i < 16; ++i) { const int kk = (i & 3) + 8 * (i >> 2) + 4 * h; const bool ok = (ch == 0) ? (kk >= r) : (kk <= r); const float pv = ok ? __builtin_amdgcn_exp2f(sa[i]) : 0.f; psum += pv; sa[i] = pv; }
                    } else {
#pragma unroll
                        for (int i = 0; i < 16; ++i) { const float pv = __builtin_amdgcn_exp2f(sa[i]); psum += pv; sa[i] = pv; }
                    }
                    lrun[m] += psum;
                    bf16x8 pf[2];
#pragma unroll
                    for (int s2 = 0; s2 < 2; ++s2) { u32x4 w; w.x = pk2(sa[8 * s2], sa[8 * s2 + 1]); w.y = pk2(sa[8 * s2 + 2], sa[8 * s2 + 3]); w.z = pk2(sa[8 * s2 + 4], sa[8 * s2 + 5]); w.w = pk2(sa[8 * s2 + 6], sa[8 * s2 + 7]);
                        pf[s2] = __builtin_bit_cast(bf16x8, w); }
#pragma unroll
                    for (int s2 = 0; s2 < 2; ++s2)
#pragma unroll
                        for (int d = 0; d < 2; ++d) {
                            const bf16_t* vp = Vt + (d * 32 + r) * 132 + kt * 32 + 16 * s2 + 4 * h;
                            const s16x4 lo = *(const s16x4*)vp, hi = *(const s16x4*)(vp + 8);
                            const bf16x8 av = __builtin_shufflevector(lo, hi, 0, 1, 2, 3, 4, 5, 6, 7);
                            o[m][d] = __builtin_amdgcn_mfma_f32_32x32x16_bf16(av, pf[s2], o[m][d], 0, 0, 0);
                        }
                }
            }
            if (nch < 5) attn_stage_store((bf16_t*)(shm + (buf ^ 1) * BUFB), (bf16_t*)(shm + (buf ^ 1) * BUFB + 18432), tid, kr, vr);
            __syncthreads();
            buf ^= 1; ch = nch;
        }
        const float sinkp = __builtin_amdgcn_exp2f(p.at_sink[hd] * LOG2E + negB);
#pragma unroll
        for (int m = 0; m < 2; ++m) {
            const float il = 1.f / (lrun[m] + __shfl_xor(lrun[m], 32) + sinkp);
            bf16_t* orow = obuf + (size_t)(b * SEQ + qs + 32 * m + r) * DM + hd * 64;
#pragma unroll
            for (int d = 0; d < 2; ++d)
#pragma unroll
                for (int gq = 0; gq < 4; ++gq) { u32x2 w; w.x = pk2(o[m][d][4 * gq] * il, o[m][d][4 * gq + 1] * il); w.y = pk2(o[m][d][4 * gq + 2] * il, o[m][d][4 * gq + 3] * il);
                    *(u32x2*)(orow + d * 32 + 8 * gq + 4 * h) = w; }
        }
    }
    __syncthreads();
}

__global__ void __launch_bounds__(512, 2) fwd_megakernel(P p) {
    extern __shared__ __attribute__((aligned(16))) unsigned char shm[];
    cg::grid_group grid = cg::this_grid();
    unsigned char* ws = p.ws;
    bf16_t* hbuf = (bf16_t*)(ws + OFF_HBUF);
    bf16_t* big = (bf16_t*)(ws + OFF_BIG);
    float* cx = (float*)(ws + OFF_CX);
    const float* modv = (const float*)(ws + OFF_MOD);

#ifndef PHASE_MASK
#define PHASE_MASK 0xffffffffu
#endif
#ifndef DUP_MASK
#define DUP_MASK 0u
#endif
#define PH(n) for (int _rep = 0; _rep < (((DUP_MASK >> (n)) & 1u) ? 2 : 1); ++_rep) if ((PHASE_MASK >> (n)) & 1u)
    if (blockIdx.x == 0) { unsigned* z = (unsigned*)(ws + OFF_NORM); for (int i = threadIdx.x; i < 8192; i += 512) z[i] = 0u; }
    PH(0) phase0(p, shm);
    grid.sync();
    if (threadIdx.x == 0) { *(volatile LAS unsigned*)(LAS unsigned char*)(shm + LDS_XB) = 0u; *((volatile LAS unsigned*)(LAS unsigned char*)(shm + LDS_XB) + 1) = 0u; }
    __syncthreads();
    const XcdBarrier xb = xcd_barrier_post((unsigned*)(ws + OFF_XBAR), (volatile LAS unsigned*)(LAS unsigned char*)(shm + LDS_XB));
    PH(1) kcgen_phase(p, shm);
    PH(1) sw_phase(p, shm);
    PH(2) norm_phase(p.x, p.ctx, p.norm1_w, modv, 0, 1, hbuf, TT, shm);
    xcd_barrier(xb);
    float* ssq = (float*)(ws + OFF_SSQ); float* ssp = (float*)(ws + OFF_SSQP); const float* swv = (const float*)(ws + OFF_SW);
    bf16_t* xgA = (bf16_t*)(ws + OFF_UT);
    const float* modv1 = modv + 9 * 6144;
    PH(3) { pg8::EpiBf16RowBias E; E.O = big; E.ldc = TT; E.bias = p.hy_b_in; run_gemm(shm, (const bf16_t*)(ws + OFF_WIN), hbuf, 3072, TT, DM, E); }
    xcd_barrier(xb);
    PH(5) fftconv_phase(p, shm);
    xcd_barrier(xb);
    PH(6) zback_phase(p, shm);
    xcd_barrier(xb);
    bf16_t* resid = (bf16_t*)p.out;
    bf16_t* cxb = (bf16_t*)cx;
    PH(7) { pg8::EpiRes<true, false, true> E; E.srcX = p.x; E.srcC = p.ctx; E.dstX = resid; E.dstC = cxb; E.bias = p.hy_b_out; E.gate = modv + 2 * 1024;
            E.xg = xgA; E.gw = p.norm2_w; E.scl = modv + 4 * 1024; E.ssq = ssp; run_gemm(shm, hbuf, (const bf16_t*)(ws + OFF_WHO), TX, DM, DM, E);
            pg8::EpiPartial Ep; Ep.part = (float*)(ws + OFF_BIG); Ep.ksplit = 4; Ep.slice = (size_t)TC * DM;
            run_gemm(shm, hbuf + (size_t)TX * DM, (const bf16_t*)(ws + OFF_WHO), TC, DM, DM / 4, Ep, DM, 4); }
    xcd_barrier(xb);
    rnorm_phase(ssp, ssq, TX);
    ctx_finalize((const float*)(ws + OFF_BIG), 4, p.ctx, p.hy_b_out, cxb, modv + 8 * 6144 + 2 * 1024, p.norm2_w, modv + 8 * 6144 + 4 * 1024, xgA + (size_t)TX * DM, ssq + TX);
    xcd_barrier(xb);
    PH(9) { pg8::EpiBf16<1, true> E; E.O = big; E.ldc = DFF; E.bias = nullptr; E.ssq = ssq; E.sw = swv; run_gemm(shm, xgA, (const bf16_t*)(ws + OFF_W1), TT, DFF, DM, E); }
    xcd_barrier(xb);
    PH(10) { pg8::EpiRes<true, true, true> E; E.srcX = resid; E.srcC = cxb; E.dstX = resid; E.dstC = cxb; E.bias = nullptr; E.gate = modv + 5 * 1024;
             E.xg = hbuf; E.gw = p.norm1_w + DM; E.scl = modv1 + 1 * 1024; E.ssq = ssp + (size_t)TT * 16; run_gemm(shm, big, (const bf16_t*)(ws + OFF_W2), TX, DM, DFF, E);
             pg8::EpiPartial Ep; Ep.part = (float*)(ws + OFF_UT); Ep.ksplit = 8; Ep.slice = (size_t)TC * DM;
             run_gemm(shm, big + (size_t)TX * DFF, (const bf16_t*)(ws + OFF_W2), TC, DM, DFF / 8, Ep, DFF, 8); }
    xcd_barrier(xb);
    rnorm_phase(ssp + (size_t)TT * 16, ssq + TT, TX);
    ctx_finalize((const float*)(ws + OFF_UT), 8, nullptr, nullptr, cxb, modv + 8 * 6144 + 5 * 1024, p.norm1_w + DM, modv1 + 8 * 6144 + 1 * 1024, hbuf + (size_t)TX * DM, ssq + TT + TX);
    xcd_barrier(xb);
    PH(12) { pg8::EpiBf16<0, true> E; E.O = big; E.ldc = 1536; E.bias = p.at_b_qkv; E.ssq = ssq + TT; E.sw = swv + 9 * 4096; run_gemm(shm, hbuf, (const bf16_t*)(ws + OFF_WQKV), TT, 1536, DM, E); }
    xcd_barrier(xb);
    PH(13) kprep_phase(p);
    xcd_barrier(xb);
    PH(14) attn_phase(p, shm);
    xcd_barrier(xb);
    bf16_t* xgB = (bf16_t*)((char*)p.out + 128 * MiB);
    PH(15) { pg8::EpiRes<true, true, true> E; E.srcX = resid; E.srcC = cxb; E.dstX = xgA; E.dstC = cxb; E.bias = p.at_b_out; E.gate = modv1 + 2 * 1024;
             E.xg = xgB; E.gw = p.norm2_w + DM; E.scl = modv1 + 4 * 1024; E.ssq = ssp + (size_t)2 * TT * 16; run_gemm(shm, hbuf, (const bf16_t*)(ws + OFF_WAO), TX, DM, DM, E); }
    xcd_barrier(xb);
    rnorm_phase(ssp + (size_t)2 * TT * 16, ssq + 2 * TT, TX);
    xcd_barrier(xb);
    PH(17) { pg8::EpiBf16<1, true> E; E.O = big; E.ldc = DFF; E.bias = nullptr; E.ssq = ssq + 2 * TT; E.sw = swv + 2 * 9 * 4096; run_gemm(shm, xgB, (const bf16_t*)(ws + OFF_W1) + (size_t)DM * DFF, TX, DFF, DM, E); }
    xcd_barrier(xb);
    PH(18) { pg8::EpiRes<false, true, false> E; E.srcX = xgA; E.srcC = cxb; E.dstX = p.out; E.dstC = cx; E.bias = nullptr; E.gate = modv1 + 5 * 1024;
             E.xg = nullptr; E.gw = nullptr; E.scl = nullptr; E.ssq = nullptr; run_gemm(shm, big, (const bf16_t*)(ws + OFF_W2) + (size_t)DM * DFF, TX, DM, DFF, E); }
}

extern "C" void kernel_launch(void* const* d_in, const int* in_sizes, int n_in, void* d_out, int out_size, void* d_ws, size_t ws_size, hipStream_t stream) {
    static int grid_blocks = 0;
    if (grid_blocks == 0) {
        if (n_in != 31 || ws_size < WS_END) { fprintf(stderr, "kernel_launch: unexpected n_in %d or ws_size %zu (< %zu)\n", n_in, ws_size, (size_t)WS_END); grid_blocks = -1; return; }
        int dev = 0, cus = 0, per_cu = 0;
        hipGetDevice(&dev);
        hipDeviceGetAttribute(&cus, hipDeviceAttributeMultiprocessorCount, dev);
        if (hipFuncSetAttribute((const void*)fwd_megakernel, hipFuncAttributeMaxDynamicSharedMemorySize, LDS_BYTES) != hipSuccess) { fprintf(stderr, "kernel_launch: hipFuncSetAttribute failed\n"); }
        hipOccupancyMaxActiveBlocksPerMultiprocessor(&per_cu, (const void*)fwd_megakernel, 512, LDS_BYTES);
        if (per_cu < 1) { fprintf(stderr, "kernel_launch: occupancy query gave %d\n", per_cu); per_cu = 1; }
        if (per_cu > 1) per_cu = 1;
        (void)hipGetLastError();
        grid_blocks = cus * per_cu;
    }
    if (grid_blocks < 0) return;
    P p{};
    const float** pp = (const float**)&p;
    for (int i = 0; i < 31; ++i) pp[i] = (const float*)d_in[i];
    p.out = (float*)d_out; p.ws = (unsigned char*)d_ws;
    void* args[] = {&p};
    hipError_t e = hipLaunchCooperativeKernel((const void*)fwd_megakernel, dim3(grid_blocks), dim3(512), args, LDS_BYTES, stream);
    if (e != hipSuccess) fprintf(stderr, "cooperative launch failed: %s (grid %d)\n", hipGetErrorString(e), grid_blocks);
}
```

```cpp
#include <hip/hip_runtime.h>
#include <hip/hip_cooperative_groups.h>
#include <cstdio>
namespace cg = cooperative_groups;

#define DI __device__ __forceinline__
#define LAS __attribute__((address_space(3)))
typedef unsigned short bf16_t;
typedef short bf16x8 __attribute__((ext_vector_type(8)));
typedef short s16x4 __attribute__((ext_vector_type(4)));
typedef float f32x4 __attribute__((ext_vector_type(4)));
typedef float f32x16 __attribute__((ext_vector_type(16)));
typedef unsigned u32x4 __attribute__((ext_vector_type(4)));
typedef unsigned u32x2 __attribute__((ext_vector_type(2)));
typedef __bf16 bf2_t __attribute__((ext_vector_type(2)));
typedef float f2_t __attribute__((ext_vector_type(2)));

constexpr int NB = 8, SEQ = 8192, DM = 1024, CL = 256, TX = NB * SEQ, TC = NB * CL, TT = TX + TC, DFF = 4096;
constexpr int LDS_XB = 128 * 129 * 8;
constexpr int LDS_SPARE = LDS_XB + 16;
constexpr int LDS_SRC0 = LDS_SPARE + 2 * 4096;
constexpr int LDS_BYTES = LDS_SRC0 + 8 * 2048;
constexpr float EPS = 1e-6f;
constexpr float LOG2E = 1.4426950408889634f;

constexpr size_t MiB = 1024 * 1024;
constexpr size_t OFF_WIN = 0;
constexpr size_t OFF_WHO = OFF_WIN + 6 * MiB;
constexpr size_t OFF_W1 = OFF_WHO + 2 * MiB;
constexpr size_t OFF_W2 = OFF_W1 + 16 * MiB;
constexpr size_t OFF_WQKV = OFF_W2 + 16 * MiB;
constexpr size_t OFF_WAO = OFF_WQKV + 3 * MiB;
constexpr size_t OFF_MOD = OFF_WAO + 2 * MiB;
constexpr size_t OFF_H2 = OFF_MOD + MiB / 2;
constexpr size_t OFF_H2C = OFF_H2 + 2 * MiB;
constexpr size_t OFF_NORM = OFF_H2C + 65536;
constexpr size_t OFF_XBAR = OFF_NORM + 16384;
constexpr size_t OFF_KCU = OFF_NORM + 65536;
constexpr size_t OFF_KCUC = OFF_KCU + 64 * MiB;
constexpr size_t OFF_KSCR = OFF_KCUC + 2 * MiB;
constexpr size_t OFF_CX = OFF_KSCR + 34 * MiB;
constexpr size_t OFF_HBUF = OFF_CX + 8 * MiB;
constexpr size_t OFF_UT = OFF_HBUF + 132 * MiB;
constexpr size_t OFF_UTC = OFF_UT + 128 * MiB;
constexpr size_t OFF_BIG = OFF_UTC + 4 * MiB;
constexpr size_t OFF_X0C = OFF_BIG + 396 * MiB;
constexpr size_t OFF_SSQ = OFF_BIG + 528 * MiB;
constexpr size_t OFF_SW = OFF_SSQ + MiB;
constexpr size_t OFF_SSQP = OFF_SW + MiB;
constexpr size_t WS_END = OFF_SSQP + 13 * MiB;

struct P {
    const float *x, *c, *ctx, *c_ctx, *mod_w, *mod_b, *norm1_w, *norm2_w, *mlp_w1, *mlp_w2, *hy_w_in, *hy_b_in, *hy_conv_w, *hy_conv_b, *hy_f_w1, *hy_f_b1, *hy_f_fr1, *hy_f_w2,
        *hy_f_b2, *hy_f_fr2, *hy_f_w3, *hy_skip, *hy_w_out, *hy_b_out, *at_w_qkv, *at_b_qkv, *at_q_norm, *at_k_norm, *at_sink, *at_w_out, *at_b_out;
    float* out;
    unsigned char* ws;
};

DI unsigned pk2(float lo, float hi) { f2_t v = {lo, hi}; bf2_t r = __builtin_convertvector(v, bf2_t); return __builtin_bit_cast(unsigned, r); }
DI float bf_lo(unsigned u) { return __uint_as_float(u << 16); }
DI float bf_hi(unsigned u) { return __uint_as_float(u & 0xffff0000u); }
DI float bf1(bf16_t b) { return __uint_as_float(((unsigned)b) << 16); }
DI bf16_t f2bf(float f) { return (bf16_t)(pk2(f, 0.f) & 0xffffu); }
DI float wave_sum(float v) {
#pragma unroll
    for (int o = 1; o < 64; o <<= 1) v += __shfl_xor(v, o);
    return v;
}
template <int CTRL> DI float dpp_mov(float v) { return __builtin_bit_cast(float, __builtin_amdgcn_update_dpp(0, __builtin_bit_cast(int, v), CTRL, 0xF, 0xF, true)); }
DI int otid() { int t = threadIdx.x; asm volatile("" : "+v"(t)); return t; }
DI void unpack8(const u32x4 w, float (&f)[8]) { f[0] = bf_lo(w.x); f[1] = bf_hi(w.x); f[2] = bf_lo(w.y); f[3] = bf_hi(w.y); f[4] = bf_lo(w.z); f[5] = bf_hi(w.z); f[6] = bf_lo(w.w); f[7] = bf_hi(w.w); }
DI u32x4 pack8(const float (&f)[8]) { u32x4 w; w.x = pk2(f[0], f[1]); w.y = pk2(f[2], f[3]); w.z = pk2(f[4], f[5]); w.w = pk2(f[6], f[7]); return w; }

#define XB_TMO      128
#define XB_XCNT(j)  (256  + 64 * (j))
#define XB_XSUB(j)  (1280 + 64 * (j))
#define XB_XGEN(j)  (2304 + 64 * (j))
#define XB_TOP      3328
#define XB_TOPGEN   3392
#define XCD_BAR_WORDS 3456
#define XB_SPIN_CAP (1u << 18)
DI unsigned xb_ld(unsigned* p)              { return __hip_atomic_load(p, __ATOMIC_RELAXED, __HIP_MEMORY_SCOPE_AGENT); }
DI unsigned xb_add(unsigned* p, unsigned v) { return __hip_atomic_fetch_add(p, v, __ATOMIC_RELAXED, __HIP_MEMORY_SCOPE_AGENT); }
DI unsigned xb_xcc_id() { return (unsigned)__builtin_amdgcn_s_getreg((3 << 11) | 20) & 0xFu; }
#define XB_SPIN(cond, bar) do { unsigned _sp = 0; while (cond) { __builtin_amdgcn_s_sleep(1); \
    if ((++_sp & 255u) == 0u) { if (xb_ld(&(bar)[XB_TMO])) break; if (_sp > XB_SPIN_CAP) { atomicAdd(&(bar)[XB_TMO], 1u); break; } } } } while (0)
struct XcdBarrier { unsigned* bar; unsigned x; volatile LAS unsigned* st; };
DI XcdBarrier xcd_barrier_post(unsigned* bar, volatile LAS unsigned* st) {
    XcdBarrier b; b.bar = bar; b.x = xb_xcc_id(); b.st = st;
    if (threadIdx.x == 0) (void)xb_add(&bar[XB_XCNT(b.x)], 1u);
    return b;
}
DI void xcd_barrier_complete(unsigned* bar, unsigned x, unsigned& nloc, unsigned& nx) {
    const unsigned G = gridDim.x * gridDim.y * gridDim.z;
    unsigned sum, cnt, mine, sp = 0u;
    for (;;) {
        sum = 0u; cnt = 0u; mine = 0u;
#pragma unroll
        for (unsigned j = 0; j < 16; ++j) { const unsigned c = xb_ld(&bar[XB_XCNT(j)]); sum += c; cnt += (c > 0u) ? 1u : 0u; mine = (j == x) ? c : mine; }
        if (sum == G) break;
        __builtin_amdgcn_s_sleep(1);
        if ((++sp & 255u) == 0u) { if (xb_ld(&bar[XB_TMO])) break; if (sp > XB_SPIN_CAP) { atomicAdd(&bar[XB_TMO], 1u); break; } }
    }
    nloc = mine > 0u ? mine : 1u; nx = cnt > 0u ? cnt : 1u;
}
DI void xcd_barrier(const XcdBarrier& b) {
    asm volatile("s_waitcnt vmcnt(0)" ::: "memory");
    __syncthreads();
    if (threadIdx.x == 0) {
        unsigned* bar = b.bar;
        __builtin_amdgcn_s_waitcnt(0);
        unsigned nloc = b.st[0], nx = b.st[1];
        if (nloc == 0u) { xcd_barrier_complete(bar, b.x, nloc, nx); b.st[0] = nloc; b.st[1] = nx; }
        const unsigned old = xb_add(&bar[XB_XSUB(b.x)], 1u);
        const unsigned gen = old / nloc;
        if (old + 1u == (gen + 1u) * nloc) {
            __builtin_amdgcn_fence(__ATOMIC_RELEASE, "agent");
            asm volatile("s_waitcnt vmcnt(0)" ::: "memory");
            const unsigned og = xb_add(&bar[XB_TOP], 1u);
            const unsigned tg = og / nx;
            if (og + 1u == (tg + 1u) * nx) xb_add(&bar[XB_TOPGEN], 1u);
            else XB_SPIN(xb_ld(&bar[XB_TOPGEN]) == tg, bar);
            __builtin_amdgcn_fence(__ATOMIC_ACQUIRE, "agent");
            xb_add(&bar[XB_XGEN(b.x)], 1u);
            asm volatile("s_waitcnt vmcnt(0)" ::: "memory");
        } else {
            XB_SPIN(xb_ld(&bar[XB_XGEN(b.x)]) == gen, bar);
            __builtin_amdgcn_fence(__ATOMIC_ACQUIRE, "agent");
            asm volatile("s_waitcnt vmcnt(0)" ::: "memory");
        }
    }
    __syncthreads();
}

namespace pg8 {
constexpr int BM = 256, BK = 64, HALF = 128, HTB = HALF * BK * 2, STAGE_BYTES = 8 * HTB, NXCD = 8, WGM = 8;
DI int lds_byte(int r, int c) { const int st = (r >> 4) * 2 + (c >> 5), rr = r & 15, cc = c & 31, ob = rr * 64 + cc * 2; return st * 1024 + (ob ^ (((ob >> 9) & 1) << 5)); }
DI void stage_rc(int b, int& R, int& C) { const int st = b / 1024, sb = b % 1024, swz = sb ^ (((sb >> 9) & 1) << 5); R = (st >> 1) * 16 + swz / 64; C = (st & 1) * 32 + (swz % 64) / 2; }
DI int perm32(int rho) { const int n = rho >> 4, i = rho & 15; return 8 * (i >> 2) + 4 * n + (i & 3); }
struct Unit { int pm, pn; };
struct Gemm { const bf16_t* A; const bf16_t* Bt; int M, N, K; int ld; int ksplit; };
struct StaticOrder {
    int nM, nN, nwg, G, c;
    DI void init(int M, int N, int G_, int c_) { nM = M / BM; nN = N / BM; nwg = nM * nN; G = G_; c = c_; }
    DI bool next(int i, Unit& u) const {
        const long L = (long)i * G + c; if (L >= nwg) return false;
        int wgid = (int)L; { const int q = nwg / NXCD, r = nwg % NXCD, xcd = wgid % NXCD, off = wgid / NXCD; wgid = (xcd < r ? xcd * (q + 1) : r * (q + 1) + (xcd - r) * q) + off; }
        const int nig = WGM * nN, gid = wgid / nig, fm = gid * WGM, gsz = (nM - fm) < WGM ? (nM - fm) : WGM;
        u.pm = fm + ((wgid % nig) % gsz); u.pn = (wgid % nig) / gsz; return true;
    }
};
template <int ACT  , bool NORM> struct EpiBf16 {
    static constexpr bool PERM = true;
    static constexpr bool PREFETCH_SRC = false;
    static constexpr bool PREFETCH = NORM;
    bf16_t* O; int ldc; const float* bias; const float* ssq; const float* sw;
    DI void prefetch(LAS unsigned char* sp, const Unit& u, int wid, int lane) const {
        if (wid > 2) return;
        const int mi = (u.pm < (TX / BM)) ? (u.pm >> 5) : 8;
        const float* base = (wid == 0) ? sw + mi * 4096 + u.pn * BM : (wid == 1) ? ssq + u.pm * BM : ((ACT == 0) ? bias + u.pn * BM : sw);
        unsigned lo = (unsigned)lane * 16u; asm volatile("" : "+v"(lo));
        if (wid < 2 || ACT == 0) __builtin_amdgcn_global_load_lds((const unsigned*)((const char*)base + lo), (LAS unsigned*)(sp + wid * 1024), 16, 0, 0);
    }
    DI void run(const f32x4 (&acc)[2][2][4][2], const Unit& u, int wr, int wc, int fr, int fq, const LAS unsigned char* sp) const {
        const int row0 = u.pm * BM + wr * 64 + fr; const int col0 = u.pn * BM + wc * 32 + 8 * fq;
        const int lc = wc * 32 + 8 * fq, lr = wr * 64 + fr;
        f32x4 bv[2][2];
#pragma unroll
        for (int bj = 0; bj < 2; ++bj)
#pragma unroll
            for (int n = 0; n < 2; ++n) { bv[bj][n] = *(const LAS f32x4*)(sp + (lc + bj * HALF + 4 * n) * 4);
                if (ACT == 0) bv[bj][n] += *(const LAS f32x4*)(sp + 2048 + (lc + bj * HALF + 4 * n) * 4); }
#pragma unroll
        for (int ai = 0; ai < 2; ++ai)
#pragma unroll
            for (int m = 0; m < 4; ++m) { const int row = row0 + ai * HALF + m * 16; bf16_t* rowp = O + (size_t)row * ldc + col0;
                const float r = *(const LAS float*)(sp + 1024 + (lr + ai * HALF + m * 16) * 4);
#pragma unroll
                for (int bj = 0; bj < 2; ++bj) { f32x4 v0 = acc[ai][bj][m][0] * r + bv[bj][0], v1 = acc[ai][bj][m][1] * r + bv[bj][1];
                    if (ACT == 1) {
#pragma unroll
                        for (int j = 0; j < 4; ++j) { const float a = fmaxf(v0[j], 0.f), b = fmaxf(v1[j], 0.f); v0[j] = a * a; v1[j] = b * b; } }
                    u32x4 w; w.x = pk2(v0[0], v0[1]); w.y = pk2(v0[2], v0[3]); w.z = pk2(v1[0], v1[1]); w.w = pk2(v1[2], v1[3]);
                    *(u32x4*)(rowp + bj * HALF) = w; } }
    }
    DI void operator()(const f32x4 (&acc)[2][2][4][2], const Unit& u, int wr, int wc, int fr, int fq) const {
        const int row0 = u.pm * BM + wr * 64 + fr; const int col0 = u.pn * BM + wc * 32 + 8 * fq;
        const int mi = (u.pm < (TX / BM)) ? (u.pm >> 5) : 8;
        f32x4 bv[2][2];
#pragma unroll
        for (int bj = 0; bj < 2; ++bj)
#pragma unroll
            for (int n = 0; n < 2; ++n) { bv[bj][n] = (ACT == 0) ? *(const f32x4*)(bias + col0 + bj * HALF + 4 * n) : (f32x4){0.f, 0.f, 0.f, 0.f};
                if (NORM) bv[bj][n] += *(const f32x4*)(sw + mi * 4096 + col0 + bj * HALF + 4 * n); }
#pragma unroll
        for (int ai = 0; ai < 2; ++ai)
#pragma unroll
            for (int m = 0; m < 4; ++m) { const int row = row0 + ai * HALF + m * 16; bf16_t* rowp = O + (size_t)row * ldc + col0;
                const float r = NORM ? ssq[row] : 1.f;
#pragma unroll
                for (int bj = 0; bj < 2; ++bj) { f32x4 v0 = acc[ai][bj][m][0] * r + bv[bj][0], v1 = acc[ai][bj][m][1] * r + bv[bj][1];
                    if (ACT == 1) {
#pragma unroll
                        for (int j = 0; j < 4; ++j) { const float a = fmaxf(v0[j], 0.f), b = fmaxf(v1[j], 0.f); v0[j] = a * a; v1[j] = b * b; } }
                    u32x4 w; w.x = pk2(v0[0], v0[1]); w.y = pk2(v0[2], v0[3]); w.z = pk2(v1[0], v1[1]); w.w = pk2(v1[2], v1[3]);
                    *(u32x4*)(rowp + bj * HALF) = w; } }
    }
};
struct EpiBf16RowBias {
    static constexpr bool PERM = true; static constexpr bool PREFETCH = true; static constexpr bool PREFETCH_SRC = false;
    bf16_t* O; size_t ldc; const float* bias;
    DI void prefetch(LAS unsigned char* sp, const Unit& u, int wid, int lane) const {
        if (wid != 0) return;
        unsigned lo = (unsigned)lane * 16u; asm volatile("" : "+v"(lo));
        __builtin_amdgcn_global_load_lds((const unsigned*)((const char*)(bias + u.pm * BM) + lo), (LAS unsigned*)sp, 16, 0, 0);
    }
    DI void run(const f32x4 (&acc)[2][2][4][2], const Unit& u, int wr, int wc, int fr, int fq, const LAS unsigned char* sp) const {
        const int row0 = u.pm * BM + wr * 64 + fr; const int col0 = u.pn * BM + wc * 32 + 8 * fq;
#pragma unroll
        for (int ai = 0; ai < 2; ++ai)
#pragma unroll
            for (int m = 0; m < 4; ++m) { const int row = row0 + ai * HALF + m * 16; const float bs = *(const LAS float*)(sp + (wr * 64 + fr + ai * HALF + m * 16) * 4); bf16_t* rowp = O + (size_t)row * ldc + col0;
#pragma unroll
                for (int bj = 0; bj < 2; ++bj) { const f32x4 v0 = acc[ai][bj][m][0] + bs, v1 = acc[ai][bj][m][1] + bs;
                    u32x4 w; w.x = pk2(v0[0], v0[1]); w.y = pk2(v0[2], v0[3]); w.z = pk2(v1[0], v1[1]); w.w = pk2(v1[2], v1[3]);
                    *(u32x4*)(rowp + bj * HALF) = w; } }
    }
};
struct EpiPartial {
    static constexpr bool PERM = true; static constexpr bool PREFETCH = false; static constexpr bool PREFETCH_SRC = false;
    float* part; int ksplit; size_t slice;
    DI void operator()(const f32x4 (&acc)[2][2][4][2], const Unit& u, int wr, int wc, int fr, int fq) const {
        const int pn = u.pn / ksplit, ks = u.pn % ksplit;
        const int row0 = u.pm * BM + wr * 64 + fr, col0 = pn * BM + wc * 32 + 8 * fq;
        float* base = part + (size_t)ks * slice;
#pragma unroll
        for (int ai = 0; ai < 2; ++ai)
#pragma unroll
            for (int m = 0; m < 4; ++m) { float* rowp = base + (size_t)(row0 + ai * HALF + m * 16) * DM + col0;
#pragma unroll
                for (int bj = 0; bj < 2; ++bj) { *(f32x4*)(rowp + bj * HALF) = acc[ai][bj][m][0]; *(f32x4*)(rowp + bj * HALF + 4) = acc[ai][bj][m][1]; } }
    }
};
template <bool FUSE, bool SRCBF, bool DSTBF> struct EpiRes {
    static constexpr bool PERM = true; static constexpr bool PREFETCH = true; static constexpr bool PREFETCH_SRC = true;
    const void* srcX; const void* srcC; void* dstX; void* dstC; const float* bias; const float* gate;
    bf16_t* xg; const float* gw; const float* scl; float* ssq;
    DI void ld_src(const void* base, size_t off, f32x4& lo, f32x4& hi) const {
        if (SRCBF) { const u32x4 w = *(const u32x4*)((const bf16_t*)base + off); lo = (f32x4){bf_lo(w.x), bf_hi(w.x), bf_lo(w.y), bf_hi(w.y)}; hi = (f32x4){bf_lo(w.z), bf_hi(w.z), bf_lo(w.w), bf_hi(w.w)}; }
        else { lo = *(const f32x4*)((const float*)base + off); hi = *(const f32x4*)((const float*)base + off + 4); }
    }
    DI void prefetch(LAS unsigned char* sp, const Unit& u, int wid, int lane) const {
        if (wid > 3) return;
        const int mi = (u.pm < (TX / BM)) ? (u.pm >> 5) : 8;
        const float* base = (wid == 0) ? gate + mi * 6144 + u.pn * BM : (wid == 1) ? (bias ? bias : gate) + u.pn * BM : (wid == 2) ? (FUSE ? gw : gate) + u.pn * BM : (FUSE ? scl : gate) + mi * 6144 + u.pn * BM;
        unsigned lo = (unsigned)lane * 16u; asm volatile("" : "+v"(lo));
        if (wid == 0 || (wid == 1 && bias) || (wid >= 2 && FUSE)) __builtin_amdgcn_global_load_lds((const unsigned*)((const char*)base + lo), (LAS unsigned*)(sp + wid * 1024), 16, 0, 0);
    }
    DI void prefetch_src(LAS unsigned char* slot, const Unit& u, int wid, int lane) const {
        if (!SRCBF) return;
        const int wr = wid >> 2, wc = wid & 3; int fr = lane & 15, fq = lane >> 4; asm volatile("" : "+v"(fr), "+v"(fq));
        const bf16_t* src = (u.pm < (TX / BM)) ? (const bf16_t*)srcX : (const bf16_t*)srcC - (size_t)TX * DM;
        const bf16_t* p0 = src + (size_t)(u.pm * BM + wr * 64 + fr) * DM + u.pn * BM + wc * 32 + 8 * fq;
        __builtin_amdgcn_global_load_lds((const unsigned*)p0, (LAS unsigned*)slot, 16, 0, 0);
        __builtin_amdgcn_global_load_lds((const unsigned*)(p0 + HALF), (LAS unsigned*)(slot + 1024), 16, 0, 0);
    }
    DI void run(const f32x4 (&acc)[2][2][4][2], const Unit& u, int wr, int wc, int fr, int fq, const LAS unsigned char* sp, const LAS unsigned char* slot, int lane) const {
        const bool lat = u.pm < (TX / BM);
        const int mi = lat ? (u.pm >> 5) : 8;
        const void* src = lat ? srcX : (const void*)((const char*)srcC - (size_t)TX * DM * (SRCBF ? 2 : 4));
        void* dst = lat ? dstX : (void*)((char*)dstC - (size_t)TX * DM * (DSTBF ? 2 : 4));
        const int row0 = u.pm * BM + wr * 64 + fr, col0 = u.pn * BM + wc * 32 + 8 * fq;
        f32x4 gv[2][2], gb[2][2], gs[2][2];
#pragma unroll
        for (int bj = 0; bj < 2; ++bj)
#pragma unroll
            for (int n = 0; n < 2; ++n) { const int lo4 = (wc * 32 + 8 * fq + bj * HALF + 4 * n) * 4; gv[bj][n] = *(const LAS f32x4*)(sp + lo4);
                gb[bj][n] = bias ? gv[bj][n] * *(const LAS f32x4*)(sp + 1024 + lo4) : (f32x4){0.f, 0.f, 0.f, 0.f};
                if (FUSE) gs[bj][n] = *(const LAS f32x4*)(sp + 2048 + lo4) * (*(const LAS f32x4*)(sp + 3072 + lo4) + 1.f); }
        f32x4 sv[2][2];
        if (SRCBF) {
#pragma unroll
            for (int bj = 0; bj < 2; ++bj) { const u32x4 w = *(const LAS u32x4*)(slot + bj * 1024 + lane * 16);
                sv[bj][0] = (f32x4){bf_lo(w.x), bf_hi(w.x), bf_lo(w.y), bf_hi(w.y)}; sv[bj][1] = (f32x4){bf_lo(w.z), bf_hi(w.z), bf_lo(w.w), bf_hi(w.w)}; }
        } else { const size_t ro = (size_t)row0 * DM + col0;
#pragma unroll
            for (int bj = 0; bj < 2; ++bj) ld_src(src, ro + bj * HALF, sv[bj][0], sv[bj][1]); }
#pragma unroll
        for (int it = 0; it < 8; ++it) { const int ai = it >> 2, m = it & 3; const int row = row0 + ai * HALF + m * 16; const size_t ro = (size_t)row * DM + col0;
            const size_t rn = (size_t)(row0 + ((it + 1) >> 2) * HALF + ((it + 1) & 3) * 16) * DM + col0;
            float ss = 0.f;
#pragma unroll
            for (int bj = 0; bj < 2; ++bj) {
                f32x4 o[2];
#pragma unroll
                for (int n = 0; n < 2; ++n) o[n] = sv[bj][n] + gv[bj][n] * acc[ai][bj][m][n] + gb[bj][n];
                if (it + 1 < 8) ld_src(src, rn + bj * HALF, sv[bj][0], sv[bj][1]);
                const size_t eo = ro + bj * HALF;
                if (DSTBF) { u32x4 w; w.x = pk2(o[0].x, o[0].y); w.y = pk2(o[0].z, o[0].w); w.z = pk2(o[1].x, o[1].y); w.w = pk2(o[1].z, o[1].w); *(u32x4*)((bf16_t*)dst + eo) = w; }
                else { *(f32x4*)((float*)dst + eo) = o[0]; *(f32x4*)((float*)dst + eo + 4) = o[1]; }
                if (FUSE) {
#pragma unroll
                    for (int n = 0; n < 2; ++n) ss += (o[n].x * o[n].x + o[n].y * o[n].y) + (o[n].z * o[n].z + o[n].w * o[n].w);
                    const f32x4 t0 = o[0] * gs[bj][0], t1 = o[1] * gs[bj][1];
                    u32x4 w; w.x = pk2(t0.x, t0.y); w.y = pk2(t0.z, t0.w); w.z = pk2(t1.x, t1.y); w.w = pk2(t1.z, t1.w); *(u32x4*)(xg + eo) = w; }
            }
            if (FUSE) { ss += __shfl_xor(ss, 16); ss += __shfl_xor(ss, 32); if (fq == 0) ssq[(size_t)row * 16 + u.pn * 4 + wc] = ss; } }
    }
};

template <class Epi>
DI void gemm_phase(LAS unsigned char* lds, const Gemm g, const StaticOrder& S, const Epi& E) {
    const int tid = otid(), wid = __builtin_amdgcn_readfirstlane(tid >> 6), lane = tid & 63, wr = wid >> 2, wc = wid & 3, fr = lane & 15, fq = lane >> 4;
    const int K = g.K, nt = K / BK, LD = g.ld, KS = g.ksplit;
    unsigned voffA[2], voffB[2];
#pragma unroll
    for (int i = 0; i < 2; ++i) { int R, C; stage_rc(tid * 16 + i * 8192, R, C); const int Rb = Epi::PERM ? ((R & ~31) + perm32(R & 31)) : R;
        voffA[i] = (unsigned)(R * LD + C) * 2u; voffB[i] = (unsigned)(Rb * LD + C) * 2u; }
    const size_t kstep = (size_t)(BK * 2);
    const size_t hstep = (size_t)HALF * LD * 2;
    const size_t kslice = (size_t)K * 2;
    const size_t tstep = 2 * hstep;
    const unsigned ldsw = (unsigned)wid * 1024u;
    const int aoff = lds_byte(wr * 64 + fr, fq * 8), boff = lds_byte(wc * 32 + fr, fq * 8);
#define PG8_SA(b, h) (((b) * 2 + (h)) * HTB)
#define PG8_SB(b, h) ((4 + (b) * 2 + (h)) * HTB)
#define PG8_STAGE(bufoff, gbase, voff) do { _Pragma("unroll") for (int _i = 0; _i < 2; ++_i) \
        __builtin_amdgcn_global_load_lds((const unsigned*)((const char*)(gbase) + (voff)[_i]), (LAS unsigned*)(lds + (bufoff) + ldsw + _i * 8192), 16, 0, 0); } while (0)
#define PG8_LDA(dst, b, h) do { _Pragma("unroll") for (int m = 0; m < 4; ++m) _Pragma("unroll") for (int k = 0; k < 2; ++k) dst[m][k] = *(const LAS bf16x8*)(lds + PG8_SA(b, h) + aoff + m * 2048 + k * 1024); } while (0)
#define PG8_LDB(dst, b, h) do { _Pragma("unroll") for (int n = 0; n < 2; ++n) _Pragma("unroll") for (int k = 0; k < 2; ++k) dst[n][k] = *(const LAS bf16x8*)(lds + PG8_SB(b, h) + boff + n * 2048 + k * 1024); } while (0)
#define PG8_MMA(ai, bj, At, Bt) do { __builtin_amdgcn_s_setprio(1); _Pragma("unroll") for (int m = 0; m < 4; ++m) _Pragma("unroll") for (int n = 0; n < 2; ++n) _Pragma("unroll") for (int k = 0; k < 2; ++k) \
        acc[ai][bj][m][n] = __builtin_amdgcn_mfma_f32_16x16x32_bf16(Bt[n][k], At[m][k], acc[ai][bj][m][n], 0, 0, 0); __builtin_amdgcn_s_setprio(0); } while (0)
#define PG8_WAIT_V(n) asm volatile("s_waitcnt vmcnt(" #n ")" ::: "memory")
#define PG8_WAIT_L(n) asm volatile("s_waitcnt lgkmcnt(" #n ")" ::: "memory")
#define PG8_BAR __builtin_amdgcn_s_barrier()
#define PG8_SCHED __builtin_amdgcn_sched_barrier(0)
    Unit cur, nxt; int ui = 0;
    if (!S.next(0, cur)) return;
    f32x4 acc[2][2][4][2];
#pragma unroll
    for (int a = 0; a < 2; ++a)
#pragma unroll
        for (int b = 0; b < 2; ++b)
#pragma unroll
            for (int m = 0; m < 4; ++m)
#pragma unroll
                for (int n = 0; n < 2; ++n) acc[a][b][m][n] = (f32x4){0.f, 0.f, 0.f, 0.f};
    bf16x8 At[4][2], B0[2][2], B1[2][2];
    const char* cA = (const char*)g.A + (size_t)cur.pm * tstep + (size_t)(cur.pn % KS) * kslice; const char* cB = (const char*)g.Bt + (size_t)(cur.pn / KS) * tstep + (size_t)(cur.pn % KS) * kslice;
    PG8_STAGE(PG8_SB(0, 0), cB, voffB); PG8_STAGE(PG8_SA(0, 0), cA, voffA); PG8_STAGE(PG8_SB(0, 1), cB + hstep, voffB); PG8_STAGE(PG8_SA(0, 1), cA + hstep, voffA);
    if (wr == 1) PG8_BAR;
    PG8_WAIT_V(4); PG8_BAR;
    PG8_STAGE(PG8_SB(1, 0), cB + kstep, voffB); PG8_STAGE(PG8_SA(1, 0), cA + kstep, voffA); PG8_STAGE(PG8_SB(1, 1), cB + hstep + kstep, voffB);
    PG8_WAIT_V(6); PG8_BAR;
    for (;;) {
        const bool has_next = S.next(ui + 1, nxt);
        const char* nA = has_next ? (const char*)g.A + (size_t)nxt.pm * tstep + (size_t)(nxt.pn % KS) * kslice : cA; const char* nB = has_next ? (const char*)g.Bt + (size_t)(nxt.pn / KS) * tstep + (size_t)(nxt.pn % KS) * kslice : cB;
        if constexpr (Epi::PREFETCH_SRC) E.prefetch_src(lds + LDS_SRC0 + wid * 2048, cur, wid, lane);
        if constexpr (Epi::PREFETCH) E.prefetch(lds + LDS_SPARE + (ui & 1) * 4096, cur, wid, lane);
        for (int t = 0; t < nt; t += 2) {
            const bool last = (t == nt - 2);
            const char* a1 = cA + (size_t)(t + 1) * kstep;
            const char* a2 = last ? nA : cA + (size_t)(t + 2) * kstep; const char* b2 = last ? nB : cB + (size_t)(t + 2) * kstep;
            const char* a3 = a2 + kstep; const char* b3 = b2 + kstep;
            PG8_LDB(B0, 0, 0); PG8_SCHED; PG8_LDA(At, 0, 0); PG8_STAGE(PG8_SA(1, 1), a1 + hstep, voffA);
            PG8_WAIT_L(8); PG8_BAR; PG8_WAIT_L(0); PG8_MMA(0, 0, At, B0); PG8_BAR; PG8_SCHED;
            PG8_LDB(B1, 0, 1); PG8_STAGE(PG8_SB(0, 0), b2, voffB);
            PG8_BAR; PG8_WAIT_L(0); PG8_MMA(0, 1, At, B1); PG8_BAR;
            PG8_LDA(At, 0, 1); PG8_STAGE(PG8_SA(0, 0), a2, voffA);
            PG8_BAR; PG8_WAIT_L(0); PG8_MMA(1, 0, At, B0); PG8_BAR; PG8_SCHED;
            PG8_STAGE(PG8_SB(0, 1), b2 + hstep, voffB);
            PG8_WAIT_V(6); PG8_BAR; PG8_MMA(1, 1, At, B1); PG8_BAR;
            PG8_LDB(B0, 1, 0); PG8_SCHED; PG8_LDA(At, 1, 0); PG8_STAGE(PG8_SA(0, 1), a2 + hstep, voffA);
            PG8_WAIT_L(8); PG8_BAR; PG8_WAIT_L(0); PG8_MMA(0, 0, At, B0); PG8_BAR; PG8_SCHED;
            PG8_LDB(B1, 1, 1); PG8_STAGE(PG8_SB(1, 0), b3, voffB);
            PG8_BAR; PG8_WAIT_L(0); PG8_MMA(0, 1, At, B1); PG8_BAR;
            PG8_LDA(At, 1, 1); PG8_STAGE(PG8_SA(1, 0), a3, voffA);
            PG8_BAR; PG8_WAIT_L(0); PG8_MMA(1, 0, At, B0); PG8_BAR; PG8_SCHED;
            PG8_STAGE(PG8_SB(1, 1), b3 + hstep, voffB);
            PG8_WAIT_V(6); PG8_BAR; PG8_MMA(1, 1, At, B1); PG8_BAR;
        }
        if constexpr (Epi::PREFETCH_SRC) E.run(acc, cur, wr, wc, fr, fq, lds + LDS_SPARE + (ui & 1) * 4096, lds + LDS_SRC0 + wid * 2048, lane);
        else if constexpr (Epi::PREFETCH) E.run(acc, cur, wr, wc, fr, fq, lds + LDS_SPARE + (ui & 1) * 4096); else E(acc, cur, wr, wc, fr, fq);
        if (!has_next) break;
#pragma unroll
        for (int a = 0; a < 2; ++a)
#pragma unroll
            for (int b = 0; b < 2; ++b)
#pragma unroll
                for (int m = 0; m < 4; ++m)
#pragma unroll
                    for (int n = 0; n < 2; ++n) acc[a][b][m][n] = (f32x4){0.f, 0.f, 0.f, 0.f};
        cur = nxt; cA = nA; cB = nB; ++ui;
    }
    PG8_WAIT_V(0);
    if (wr == 0) PG8_BAR;
    PG8_BAR;
#undef PG8_SA
#undef PG8_SB
#undef PG8_STAGE
#undef PG8_LDA
#undef PG8_LDB
#undef PG8_MMA
#undef PG8_WAIT_V
#undef PG8_WAIT_L
#undef PG8_BAR
#undef PG8_SCHED
}
}

template <class Epi> DI void run_gemm(unsigned char* shm, const bf16_t* A, const bf16_t* Bt, int M, int N, int K, const Epi& E, int ld = 0, int ksplit = 1) {
    pg8::Gemm g; g.A = A; g.Bt = Bt; g.M = M; g.N = N; g.K = K; g.ld = ld ? ld : K; g.ksplit = ksplit;
    pg8::StaticOrder S; S.init(M, N * ksplit, (int)gridDim.x, (int)blockIdx.x);
    pg8::gemm_phase<Epi>((LAS unsigned char*)shm, g, S, E);
    __syncthreads();
}

DI void transpose_item(const float* W, int K, int N, bf16_t* WT, float* scr, int item, int lane) {
    const int nblk = N / 32, kb = item / nblk, nb = item % nblk, k0 = 64 * kb, n0 = 32 * nb;
#pragma unroll 8
    for (int i = 0; i < 32; ++i) { const int kk = 2 * i + (lane >> 5); scr[kk * 33 + (lane & 31)] = W[(size_t)(k0 + kk) * N + n0 + (lane & 31)]; }
    asm volatile("s_waitcnt lgkmcnt(0)" ::: "memory");
    const int c = lane & 7;
#pragma unroll
    for (int j = 0; j < 4; ++j) { const int n = (lane >> 3) + 8 * j; const float* s = scr + (8 * c) * 33 + n;
        u32x4 o; o.x = pk2(s[0 * 33], s[1 * 33]); o.y = pk2(s[2 * 33], s[3 * 33]); o.z = pk2(s[4 * 33], s[5 * 33]); o.w = pk2(s[6 * 33], s[7 * 33]);
        *(u32x4*)(WT + (size_t)(n0 + n) * K + k0 + 8 * c) = o; }
    asm volatile("s_waitcnt lgkmcnt(0)" ::: "memory");
}

DI void phase0(const P& p, unsigned char* shm) {
    const int tid = otid(), lane = tid & 63, wid = tid >> 6;
    unsigned char* ws = p.ws;
    {
        float* scr = (float*)shm + wid * (64 * 33);
        const int gw = blockIdx.x * 8 + wid, NGW = gridDim.x * 8;
        constexpr int I_IN = 16 * 96, I_HO = 16 * 32, I_1 = 16 * 128, I_2 = 64 * 32, I_QKV = 16 * 48, I_AO = 16 * 32;
        constexpr int NITEMS = I_IN + I_HO + 2 * I_1 + 2 * I_2 + I_QKV + I_AO;
        for (int it = gw; it < NITEMS; it += NGW) {
            int r = it;
            if (r < I_IN) { transpose_item(p.hy_w_in, DM, 3 * DM, (bf16_t*)(ws + OFF_WIN), scr, r, lane); continue; } r -= I_IN;
            if (r < I_HO) { transpose_item(p.hy_w_out, DM, DM, (bf16_t*)(ws + OFF_WHO), scr, r, lane); continue; } r -= I_HO;
            if (r < 2 * I_1) { const int l = r / I_1; transpose_item(p.mlp_w1 + (size_t)l * DM * DFF, DM, DFF, (bf16_t*)(ws + OFF_W1) + (size_t)l * DM * DFF, scr, r % I_1, lane); continue; } r -= 2 * I_1;
            if (r < 2 * I_2) { const int l = r / I_2; transpose_item(p.mlp_w2 + (size_t)l * DM * DFF, DFF, DM, (bf16_t*)(ws + OFF_W2) + (size_t)l * DM * DFF, scr, r % I_2, lane); continue; } r -= 2 * I_2;
            if (r < I_QKV) { transpose_item(p.at_w_qkv, DM, 1536, (bf16_t*)(ws + OFF_WQKV), scr, r, lane); continue; } r -= I_QKV;
            transpose_item(p.at_w_out, DM, DM, (bf16_t*)(ws + OFF_WAO), scr, r, lane);
        }
    }
    __syncthreads();
    {
        float* sv = (float*)shm;
        float* part = sv + 9 * 1024;
        float* modv = (float*)(ws + OFF_MOD);
        bool filled = false;
        for (int it = blockIdx.x; it < 2 * 96; it += gridDim.x) {
            if (!filled) {
                for (int i = tid; i < 9 * 1024; i += 512) { const float v = (i < 8192) ? p.c[i] : p.c_ctx[i - 8192]; sv[i] = v / (1.f + __expf(-v)); }
                filled = true;
            }
            __syncthreads();
            const int l = it / 96, n0 = (it % 96) * 64;
            const float* w = p.mod_w + (size_t)l * DM * 6144 + n0 + lane;
            float acc[9];
#pragma unroll
            for (int bb = 0; bb < 9; ++bb) acc[bb] = 0.f;
            const int kb = wid * 128;
#pragma unroll 4
            for (int k = 0; k < 128; ++k) { const float wv = w[(size_t)(kb + k) * 6144];
#pragma unroll
                for (int bb = 0; bb < 9; ++bb) acc[bb] += sv[bb * 1024 + kb + k] * wv; }
#pragma unroll
            for (int bb = 0; bb < 9; ++bb) part[(wid * 9 + bb) * 64 + lane] = acc[bb];
            __syncthreads();
            for (int o = tid; o < 9 * 64; o += 512) { const int bb = o >> 6, n = o & 63; float s = p.mod_b[l * 6144 + n0 + n];
#pragma unroll
                for (int w8 = 0; w8 < 8; ++w8) s += part[(w8 * 9 + bb) * 64 + n];
                modv[(l * 9 + bb) * 6144 + n0 + n] = s; }
        }
    }
    __syncthreads();
    {
        float* zs = (float*)shm;
        float* h1 = zs + 8 * 40;
        const int tl = tid >> 6, j = lane;
        for (int it = blockIdx.x; it < 1024 + 32; it += gridDim.x) {
            const bool cx = it >= 1024; const int Ls = cx ? CL : SEQ; const int pos = (cx ? (it - 1024) : it) * 8 + tl;
            __syncthreads();
            if (j < 33) { float zv;
                if (j == 0) zv = (float)pos / (float)Ls;
                else { const int bi = (j - 1) & 15; const float band = 1e-4f + (float)bi * ((15.f - 1e-4f) / 15.f); const float turns = (float)pos * band / (float)Ls;
                    zv = (j <= 16) ? __builtin_amdgcn_cosf(turns) : -__builtin_amdgcn_sinf(turns); }
                zs[tl * 40 + j] = zv; }
            __syncthreads();
            { float a = p.hy_f_b1[j];
#pragma unroll 3
                for (int i = 0; i < 33; ++i) a += zs[tl * 40 + i] * p.hy_f_w1[i * 64 + j];
                h1[tl * 64 + j] = __sinf(p.hy_f_fr1[j] * a); }
            __syncthreads();
            { float a = p.hy_f_b2[j];
#pragma unroll 4
                for (int k = 0; k < 64; ++k) a += h1[tl * 64 + k] * p.hy_f_w2[k * 64 + j];
                float* H = (float*)(ws + (cx ? OFF_H2C : OFF_H2));
                H[(size_t)pos * 64 + j] = __sinf(p.hy_f_fr2[j] * a); }
        }
    }
    __syncthreads();
}

DI void kcgen_phase(const P& p, unsigned char* shm) {
    const int tid = otid(); const int lane = tid & 63, wid = __builtin_amdgcn_readfirstlane(tid >> 6);
    unsigned char* ws = p.ws;
    float* w3s = (float*)shm;
    const float* __restrict__ w3 = p.hy_f_w3;
    for (int it = blockIdx.x; it < 256; it += gridDim.x) {
        const int cc = it & 15, tg = it >> 4;
        __syncthreads();
        { const int k = tid >> 3, ci8 = (tid & 7) * 8;
#pragma unroll
            for (int dir = 0; dir < 2; ++dir) { const float* src = w3 + (size_t)k * 2048 + dir * 1024 + cc * 64 + ci8;
                const f32x4 v0 = *(const f32x4*)src, v1 = *(const f32x4*)(src + 4);
                float* d = w3s + (dir * 64 + ci8) * 64 + k;
                d[0] = v0.x; d[64] = v0.y; d[128] = v0.z; d[192] = v0.w; d[256] = v1.x; d[320] = v1.y; d[384] = v1.z; d[448] = v1.w; } }
        __syncthreads();
#pragma unroll 1
        for (int part = 0; part < 2; ++part) {
            const bool cx = part == 1; const int Ls = cx ? CL : SEQ;
            if (cx && wid >= 4) break;
            const int t = (cx ? wid : tg * 8 + wid) * 64 + lane;
            const float* H = (const float*)(ws + (cx ? OFF_H2C : OFF_H2)) + (size_t)t * 64;
            float h[64];
#pragma unroll
            for (int k = 0; k < 16; ++k) { const f32x4 v = *(const f32x4*)(H + 4 * k); h[4 * k] = v.x; h[4 * k + 1] = v.y; h[4 * k + 2] = v.z; h[4 * k + 3] = v.w; }
            float* kc = (float*)(ws + (cx ? OFF_KCUC : OFF_KCU));
            float* nrm = (float*)(ws + OFF_NORM) + (cx ? 1024 : 0);
            const float tf = (float)t / (float)Ls;
            const int ci_lo = cx ? 4 * tg : 0, ci_hi = cx ? 4 * tg + 4 : 64;
#pragma unroll 1
            for (int ci = ci_lo; ci < ci_hi; ++ci) {
                const int c = cc * 64 + ci;
                float af = 0.f, ab = 0.f;
#pragma unroll
                for (int k4 = 0; k4 < 16; ++k4) { const f32x4 wf = *(const f32x4*)(w3s + ci * 64 + 4 * k4), wb = *(const f32x4*)(w3s + (64 + ci) * 64 + 4 * k4);
                    af += h[4 * k4] * wf.x; af += h[4 * k4 + 1] * wf.y; af += h[4 * k4 + 2] * wf.z; af += h[4 * k4 + 3] * wf.w;
                    ab += h[4 * k4] * wb.x; ab += h[4 * k4 + 1] * wb.y; ab += h[4 * k4 + 2] * wb.z; ab += h[4 * k4 + 3] * wb.w; }
                const float delta = fabsf(-3.0701134573253945f + (float)c * ((-15.350567286626973f + 3.0701134573253945f) / 1023.f));
                const float dec = __expf(-tf * delta);
                const float vf = af * dec, vb = ab * dec;
                float* row = kc + (size_t)c * (2 * Ls);
                row[t] = vf;
                if (t >= 1) row[2 * Ls - t] = vb; else row[Ls] = 0.f;
                float sabs = fabsf(vf) + (t >= 1 ? fabsf(vb) : 0.f);
                sabs = wave_sum(sabs);
                if (lane == 0) atomicAdd(nrm + c, sabs);
            }
        }
    }
    __syncthreads();
}

DI void sw_phase(const P& p, unsigned char* shm) {
    const int tid = otid(), lane = tid & 63, wid = tid >> 6;
    unsigned char* ws = p.ws;
    float* sv = (float*)shm;
    float* part = sv + 9 * 1024;
    const float* modv = (const float*)(ws + OFF_MOD);
    for (int it = blockIdx.x; it < 64 + 24 + 64; it += gridDim.x) {
        int j, n0, ldw; const float* W; const float* shv;
        if (it < 64) { j = 0; n0 = it * 64; ldw = DFF; W = p.mlp_w1; shv = modv + 3 * 1024; }
        else if (it < 88) { j = 1; n0 = (it - 64) * 64; ldw = 1536; W = p.at_w_qkv; shv = modv + 9 * 6144; }
        else { j = 2; n0 = (it - 88) * 64; ldw = DFF; W = p.mlp_w1 + (size_t)DM * DFF; shv = modv + 9 * 6144 + 3 * 1024; }
        __syncthreads();
        for (int i = tid; i < 9 * 1024; i += 512) sv[i] = shv[(i >> 10) * 6144 + (i & 1023)];
        __syncthreads();
        const float* w = W + n0 + lane;
        float acc[9];
#pragma unroll
        for (int bb = 0; bb < 9; ++bb) acc[bb] = 0.f;
        const int kb = wid * 128;
#pragma unroll 4
        for (int k = 0; k < 128; ++k) { const float wv = w[(size_t)(kb + k) * ldw];
#pragma unroll
            for (int bb = 0; bb < 9; ++bb) acc[bb] += sv[bb * 1024 + kb + k] * wv; }
#pragma unroll
        for (int bb = 0; bb < 9; ++bb) part[(wid * 9 + bb) * 64 + lane] = acc[bb];
        __syncthreads();
        float* sw = (float*)(ws + OFF_SW) + j * 9 * 4096;
        for (int o = tid; o < 9 * 64; o += 512) { const int bb = o >> 6, n = o & 63; float a = 0.f;
#pragma unroll
            for (int w8 = 0; w8 < 8; ++w8) a += part[(w8 * 9 + bb) * 64 + n];
            sw[bb * 4096 + n0 + n] = a; }
    }
    __syncthreads();
}

DI void rnorm_phase(const float* part, float* r, int nrows) {
    const int tid = otid();
    for (int row = blockIdx.x * 512 + tid; row < nrows; row += gridDim.x * 512) {
        const f32x4* q = (const f32x4*)(part + (size_t)row * 16);
        const f32x4 a = q[0], b = q[1], c = q[2], d = q[3];
        const float ssum = ((a.x + a.y) + (a.z + a.w)) + ((b.x + b.y) + (b.z + b.w)) + ((c.x + c.y) + (c.z + c.w)) + ((d.x + d.y) + (d.z + d.w));
        r[row] = __builtin_amdgcn_rsqf(ssum * (1.f / DM) + EPS);
    }
}

DI void ctx_finalize(const float* part, int ksplit, const float* srcf  , const float* bias, bf16_t* cxb, const float* gate8, const float* gw, const float* scl8, bf16_t* xgc, float* rc) {
    const int tid = otid(); const int lane = tid & 63, wid = tid >> 6;
    for (int row = blockIdx.x * 8 + wid; row < TC; row += gridDim.x * 8) {
        f32x4 a[4];
#pragma unroll
        for (int j = 0; j < 4; ++j) a[j] = (f32x4){0.f, 0.f, 0.f, 0.f};
        for (int ks = 0; ks < ksplit; ++ks) { const float* pr = part + ((size_t)ks * TC + row) * DM + 4 * lane;
#pragma unroll
            for (int j = 0; j < 4; ++j) a[j] += *(const f32x4*)(pr + 256 * j); }
        float ss = 0.f; f32x4 o[4];
#pragma unroll
        for (int j = 0; j < 4; ++j) { const int c = 4 * lane + 256 * j; f32x4 sv;
            if (srcf) sv = *(const f32x4*)(srcf + (size_t)row * DM + c);
            else { const u32x2 w = *(const u32x2*)(cxb + (size_t)row * DM + c); sv = (f32x4){bf_lo(w.x), bf_hi(w.x), bf_lo(w.y), bf_hi(w.y)}; }
            if (bias) a[j] += *(const f32x4*)(bias + c);
            o[j] = sv + *(const f32x4*)(gate8 + c) * a[j];
            ss += (o[j].x * o[j].x + o[j].y * o[j].y) + (o[j].z * o[j].z + o[j].w * o[j].w); }
        ss = wave_sum(ss);
        if (lane == 0) rc[row] = __builtin_amdgcn_rsqf(ss * (1.f / DM) + EPS);
#pragma unroll
        for (int j = 0; j < 4; ++j) { const int c = 4 * lane + 256 * j;
            u32x2 w; w.x = pk2(o[j].x, o[j].y); w.y = pk2(o[j].z, o[j].w); *(u32x2*)(cxb + (size_t)row * DM + c) = w;
            const f32x4 t = o[j] * (*(const f32x4*)(gw + c)) * (*(const f32x4*)(scl8 + c) + 1.f);
            u32x2 x; x.x = pk2(t.x, t.y); x.y = pk2(t.z, t.w); *(u32x2*)(xgc + (size_t)row * DM + c) = x; }
    }
}

DI void norm_phase(const float* srcX, const float* srcC, const float* g, const float* modl  , int shift_chunk, int scale_chunk, bf16_t* hbuf, int nrows, unsigned char* shm) {
    const int tid = otid(); const int lane = tid & 63, wid = tid >> 6;
    const int gw = blockIdx.x * 8 + wid, NGW = gridDim.x * 8;
    f32x4 gv[4];
#pragma unroll
    for (int j = 0; j < 4; ++j) gv[j] = *(const f32x4*)(g + 4 * lane + 256 * j);
    float* shs = (float*)shm; float* scs = shs + 9 * 1024;
    __syncthreads();
    for (int i = tid; i < 9 * 1024; i += 512) { const int mi = i >> 10, c = i & 1023; shs[i] = modl[mi * 6144 + shift_chunk * 1024 + c]; scs[i] = modl[mi * 6144 + scale_chunk * 1024 + c]; }
    __syncthreads();
    for (int row0 = gw; row0 < nrows; row0 += 2 * NGW) {
        f32x4 v[2][4];
#pragma unroll
        for (int rr = 0; rr < 2; ++rr) { const int row = row0 + rr * NGW; const bool lat = row < TX;
            const float* xr = lat ? srcX + (size_t)row * DM : srcC + (size_t)(row - TX) * DM;
#pragma unroll
            for (int j = 0; j < 4; ++j) v[rr][j] = (row < nrows) ? *(const f32x4*)(xr + 4 * lane + 256 * j) : (f32x4){0.f, 0.f, 0.f, 0.f}; }
#pragma unroll
        for (int rr = 0; rr < 2; ++rr) { const int row = row0 + rr * NGW; const bool lat = row < TX; const int mi = lat ? (row >> 13) : 8;
            float ss = 0.f;
#pragma unroll
            for (int j = 0; j < 4; ++j) ss += (v[rr][j].x * v[rr][j].x + v[rr][j].y * v[rr][j].y) + (v[rr][j].z * v[rr][j].z + v[rr][j].w * v[rr][j].w);
            ss = wave_sum(ss);
            const float r = __builtin_amdgcn_rsqf(ss * (1.f / DM) + EPS);
            const float* sh = shs + mi * 1024; const float* sc = scs + mi * 1024;
            if (row < nrows) { bf16_t* orow = hbuf + (size_t)row * DM;
#pragma unroll
                for (int j = 0; j < 4; ++j) { const f32x4 s4 = *(const f32x4*)(sh + 4 * lane + 256 * j), c1 = *(const f32x4*)(sc + 4 * lane + 256 * j);
                    const f32x4 y = v[rr][j] * r * gv[j] * (c1 + 1.f) + s4;
                    u32x2 w; w.x = pk2(y.x, y.y); w.y = pk2(y.z, y.w);
                    *(u32x2*)(orow + 4 * lane + 256 * j) = w; } }
        }
    }
}

DI void conv_item_coords(int item, int& b, int& tt, int& ct, int& rowb, int& Ls) {
    if (item < 16384) { ct = item & 15; tt = (item >> 4) & 127; b = item >> 11; rowb = b * SEQ; Ls = SEQ; }
    else { const int j = item - 16384; ct = j & 15; tt = (j >> 4) & 3; b = j >> 6; rowb = TX + b * CL; Ls = CL; }
}
DI void conv8(const bf16_t* seq, int t0, int Ls, float w0, float w1, float w2, float cb, float (&o)[8]) {
    float xm[8]; unpack8(*(const u32x4*)(seq + t0), xm);
    const float xl = (t0 > 0) ? bf1(seq[t0 - 1]) : 0.f, xr = (t0 + 8 < Ls) ? bf1(seq[t0 + 8]) : 0.f;
    o[0] = cb + w0 * xl + w1 * xm[0] + w2 * xm[1];
#pragma unroll
    for (int e = 1; e < 7; ++e) o[e] = cb + w0 * xm[e - 1] + w1 * xm[e] + w2 * xm[e + 1];
    o[7] = cb + w0 * xm[6] + w1 * xm[7] + w2 * xr;
}
struct ZIn { u32x4 x, y; float xl, xr, w0, w1, w2, cb; };
DI void zback_load(const P& p, int item, int tid, ZIn& z) {
    int b, tt, ct, rowb, Ls; conv_item_coords(item, b, tt, ct, rowb, Ls);
    const int cl = tid >> 3, t8 = (tid & 7) * 8, c = ct * 64 + cl, t0 = tt * 64 + t8;
    const bf16_t* seq = (const bf16_t*)(p.ws + OFF_BIG) + (size_t)c * TT + rowb;
    z.x = *(const u32x4*)(seq + t0);
    z.xl = (t0 > 0) ? bf1(seq[t0 - 1]) : 0.f; z.xr = (t0 + 8 < Ls) ? bf1(seq[t0 + 8]) : 0.f;
    z.y = *(const u32x4*)((Ls == SEQ) ? (const bf16_t*)(p.ws + OFF_UT) + ((size_t)(b * DM + c)) * SEQ + t0 : (const bf16_t*)(p.ws + OFF_UTC) + ((size_t)(b * DM + c)) * CL + t0);
    z.w0 = p.hy_conv_w[c]; z.w1 = p.hy_conv_w[3072 + c]; z.w2 = p.hy_conv_w[6144 + c]; z.cb = p.hy_conv_b[c];
}
DI void zback_phase(const P& p, unsigned char* shm) {
    const int tid = otid();
    bf16_t* hbuf = (bf16_t*)(p.ws + OFF_HBUF);
    bf16_t* zs = (bf16_t*)shm;
    constexpr int NIT = 16384 + 512;
    ZIn cur, nxt, nx2;
    int item = blockIdx.x;
    if (item < NIT) zback_load(p, item, tid, cur);
    if (item + (int)gridDim.x < NIT) zback_load(p, item + gridDim.x, tid, nxt); else nxt = cur;
    for (; item < NIT; item += gridDim.x) {
        const int nitem = item + 2 * gridDim.x;
        if (nitem < NIT) zback_load(p, nitem, tid, nx2); else nx2 = nxt;
        int b, tt, ct, rowb, Ls; conv_item_coords(item, b, tt, ct, rowb, Ls);
        { const int cl = tid >> 3, t8 = (tid & 7) * 8;
            float xm[8], yv[8], o[8]; unpack8(cur.x, xm); unpack8(cur.y, yv);
            o[0] = cur.cb + cur.w0 * cur.xl + cur.w1 * xm[0] + cur.w2 * xm[1];
#pragma unroll
            for (int e = 1; e < 7; ++e) o[e] = cur.cb + cur.w0 * xm[e - 1] + cur.w1 * xm[e] + cur.w2 * xm[e + 1];
            o[7] = cur.cb + cur.w0 * xm[6] + cur.w1 * xm[7] + cur.w2 * cur.xr;
#pragma unroll
            for (int e = 0; e < 8; ++e) o[e] *= yv[e];
            __syncthreads();
            *(u32x4*)(zs + cl * 72 + t8) = pack8(o); }
        __syncthreads();
        { const int tl = tid >> 3, c8 = (tid & 7) * 8;
            float z[8];
#pragma unroll
            for (int e = 0; e < 8; ++e) z[e] = bf1(zs[(c8 + e) * 72 + tl]);
            *(u32x4*)(hbuf + (size_t)(rowb + tt * 64 + tl) * DM + ct * 64 + c8) = pack8(z); }
        cur = nxt; nxt = nx2;
    }
    __syncthreads();
}

constexpr float C16[8] = {1.f, 0.92387953251128674f, 0.70710678118654752f, 0.38268343236508977f, 0.f, -0.38268343236508977f, -0.70710678118654752f, -0.92387953251128674f};
constexpr float S16[8] = {0.f, 0.38268343236508977f, 0.70710678118654752f, 0.92387953251128674f, 1.f, 0.92387953251128674f, 0.70710678118654752f, 0.38268343236508977f};
DI f2_t cmul(f2_t a, f2_t w) { return (f2_t){a.x, a.x} * w + (f2_t){a.y, a.y} * (f2_t){-w.y, w.x}; }
DI f2_t cmulc(f2_t a, f2_t w) { return (f2_t){a.x, a.x} * (f2_t){w.x, -w.y} + (f2_t){a.y, a.y} * (f2_t){w.y, w.x}; }
DI f2_t mul_mi(f2_t a) { return (f2_t){a.y, -a.x}; }
DI f2_t mul_pi(f2_t a) { return (f2_t){-a.y, a.x}; }
template <int R, int LEN, bool INV> DI void dif_stages(f2_t (&x)[R]) {
    constexpr int half = LEN / 2, ts = 16 / LEN;
#pragma unroll
    for (int blk = 0; blk < R; blk += LEN)
#pragma unroll
        for (int j = 0; j < half; ++j) {
            const int i0 = blk + j, i1 = i0 + half;
            const f2_t a = x[i0], b = x[i1];
            x[i0] = a + b;
            const f2_t t = a - b;
            const int k = j * ts;
            if (k == 0) x[i1] = t;
            else if (k == 4) x[i1] = INV ? mul_pi(t) : mul_mi(t);
            else { const f2_t w = {C16[k], S16[k]}; x[i1] = INV ? cmul(t, w) : cmulc(t, w); }
        }
    if constexpr (LEN > 2) dif_stages<R, LEN / 2, INV>(x);
}
template <int R> DI constexpr int brev(int p) { int r = 0; for (int i = 0, b = (R == 8 ? 3 : 4); i < b; ++i) r |= ((p >> i) & 1) << (b - 1 - i); return r; }

template <int PASS, bool INV> DI void bfly_addr(int q, int& a0, int& astr, int& np) {
    if (PASS == 1) { a0 = (q >> 7) * 129 + (q & 127); astr = 16 * 129; np = q; }
    else if (PASS == 2) { a0 = (q >> 7) * 16 * 129 + (q & 127); astr = 129; np = q & 127; }
    else if (PASS == 3) { a0 = (q & 127) * 129 + (q >> 7); astr = 16; np = q >> 7; }
    else { a0 = (q & 127) * 129 + (q >> 7) * 16; astr = 1; np = 0; }
    if (PASS != 4) asm volatile("" : "+v"(np));
}
template <int R> DI void tw_powers(f2_t w1, f2_t (&pw)[R]) {
    pw[1] = w1;
#pragma unroll
    for (int k = 2; k < R; ++k) { const int hb = (k >= 8) ? 8 : (k >= 4) ? 4 : 2; const int lo = k - hb;
        if (lo == 0) pw[k] = cmul(pw[hb / 2], pw[hb / 2]); else pw[k] = cmul(pw[hb], pw[lo]); }
}
template <int PASS, bool INV, int MODE, int R> DI void bfly_compute(f2_t (&x)[R], int np) {
    constexpr float invM = (PASS == 1) ? (1.f / 16384.f) : (PASS == 2) ? (1.f / 2048.f) : (1.f / 128.f);
    f2_t pw[R];
    if (PASS != 4) { const float turns = (float)np * invM; f2_t w1 = {__builtin_amdgcn_cosf(turns), __builtin_amdgcn_sinf(turns)}; if (!INV) w1.y = -w1.y; tw_powers<R>(w1, pw); }
    if (INV && PASS != 4) {
#pragma unroll
        for (int k = 1; k < R; ++k) x[k] = cmul(x[k], pw[k]);
    }
    if (MODE == 1) {
        x[4] = x[0]; x[5] = cmulc(x[1], (f2_t){S16[2], S16[2]}); x[6] = mul_mi(x[2]); x[7] = cmulc(x[3], (f2_t){-S16[2], S16[2]});
        dif_stages<R, 4, INV>(x);
    } else dif_stages<R, R, INV>(x);
    if (!INV && PASS != 4) {
#pragma unroll
        for (int k = 1; k < R; ++k) { const int pp = brev<R>(k); x[pp] = cmul(x[pp], pw[k]); }
    }
}
template <int PASS, bool INV, int MODE> DI void fft_pass(f2_t* lds, int tid, const f2_t* kmul, f2_t* kout, float sc) {
    constexpr int R = (PASS == 1 || PASS == 3) ? 8 : 16;
    constexpr int NBF = 16384 / R;
    constexpr int RL = (MODE == 1) ? R / 2 : R;
#pragma unroll 1
    for (int q = tid; q < NBF; q += 1024) {
        int a0A, asA, npA, a0B, asB, npB;
        bfly_addr<PASS, INV>(q, a0A, asA, npA); bfly_addr<PASS, INV>(q + 512, a0B, asB, npB);
        f2_t xA[R], xB[R];
#pragma unroll
        for (int n = 0; n < RL; ++n) { xA[n] = lds[a0A + n * asA]; xB[n] = lds[a0B + n * asB]; }
        bfly_compute<PASS, INV, MODE, R>(xA, npA);
        bfly_compute<PASS, INV, MODE, R>(xB, npB);
#pragma unroll
        for (int pp = 0; pp < R; ++pp) {
            if (MODE == 4 && (pp & 1)) continue;
            const int aA = a0A + brev<R>(pp) * asA, aB = a0B + brev<R>(pp) * asB;
            f2_t v = xA[pp], w = xB[pp];
            if (MODE == 2) { v = cmul(v, kmul[aA]); w = cmul(w, kmul[aB]); }
            if (MODE == 3) { v = v * sc; w = w * sc; kout[aA] = v; kout[aB] = w; }
            else { lds[aA] = v; lds[aB] = w; }
        }
    }
    __syncthreads();
}

DI void fftconv_phase(const P& p, unsigned char* shm) {
    const int tid = otid(), lane = tid & 63, wid = tid >> 6;
    unsigned char* ws = p.ws;
    f2_t* lds = (f2_t*)shm;
    f2_t* kscr2 = (f2_t*)(ws + OFF_HBUF) + (size_t)blockIdx.x * (2 * 16512);
    const float* nrm = (const float*)(ws + OFF_NORM);
    for (int cpair = blockIdx.x; cpair < DM; cpair += 2 * gridDim.x)
    for (int which = 0; which < 2; ++which) {
        const int c = cpair + which * gridDim.x;
        if (c >= DM) break;
        f2_t* kscr = kscr2 + which * 16512;
        if (which == 0) {
            const int cB = cpair + gridDim.x; const bool hasB = cB < DM;
            __syncthreads();
            { const float* kcA = (const float*)(ws + OFF_KCU) + (size_t)cpair * 16384; const float* kcB = (const float*)(ws + OFF_KCU) + (size_t)(hasB ? cB : cpair) * 16384;
#pragma unroll 4
                for (int i = tid * 4; i < 16384; i += 2048) { const f32x4 v = *(const f32x4*)(kcA + i); f32x4 w = *(const f32x4*)(kcB + i); if (!hasB) w = (f32x4){0.f, 0.f, 0.f, 0.f};
                    const int a = (i >> 7) * 129 + (i & 127);
                    lds[a] = (f2_t){v.x, w.x}; lds[a + 1] = (f2_t){v.y, w.y}; lds[a + 2] = (f2_t){v.z, w.z}; lds[a + 3] = (f2_t){v.w, w.w}; } }
            __syncthreads();
            fft_pass<1, false, 0>(lds, tid, nullptr, nullptr, 0.f); fft_pass<2, false, 0>(lds, tid, nullptr, nullptr, 0.f); fft_pass<3, false, 0>(lds, tid, nullptr, nullptr, 0.f);
            fft_pass<4, false, 0>(lds, tid, nullptr, nullptr, 0.f);
            { const float sA = 0.5f / (16384.f * nrm[cpair]), sB = 0.5f / (16384.f * nrm[hasB ? cB : cpair]);
#pragma unroll 4
                for (int pq = tid; pq < 16384; pq += 512) {
                    const int k = (pq >> 11) + (((pq >> 7) & 15) << 3) + (((pq >> 4) & 7) << 7) + ((pq & 15) << 10);
                    const int kn = (16384 - k) & 16383;
                    const int pn = ((kn & 7) << 11) + (((kn >> 3) & 15) << 7) + (((kn >> 7) & 7) << 4) + (kn >> 10);
                    const int a = (pq >> 7) * 129 + (pq & 127), an = (pn >> 7) * 129 + (pn & 127);
                    const f2_t z = lds[a], zn = lds[an];
                    kscr2[a] = (f2_t){(z.x + zn.x) * sA, (z.y - zn.y) * sA};
                    kscr2[16512 + a] = (f2_t){(z.y + zn.y) * sB, (zn.x - z.x) * sB}; } }
        }
        const float skip = p.hy_skip[c];
        const bf16_t* x1r = (const bf16_t*)(ws + OFF_BIG) + (size_t)(DM + c) * TT; const bf16_t* vr = (const bf16_t*)(ws + OFF_BIG) + (size_t)(2 * DM + c) * TT;
        const float wx0 = p.hy_conv_w[DM + c], wx1 = p.hy_conv_w[3072 + DM + c], wx2 = p.hy_conv_w[6144 + DM + c], cbx = p.hy_conv_b[DM + c];
        const float wv0 = p.hy_conv_w[2 * DM + c], wv1 = p.hy_conv_w[3072 + 2 * DM + c], wv2 = p.hy_conv_w[6144 + 2 * DM + c], cbv = p.hy_conv_b[2 * DM + c];
#pragma unroll 1
        for (int bp = 0; bp < 4; ++bp) {
            bf16_t* u0 = (bf16_t*)(ws + OFF_UT) + ((size_t)((2 * bp) * DM + c)) * SEQ;
            bf16_t* u1 = u0 + (size_t)DM * SEQ;
            const bf16_t* sx = x1r + (2 * bp) * SEQ; const bf16_t* sv = vr + (2 * bp) * SEQ;
            __syncthreads();
#pragma unroll
            for (int jj = 0; jj < 2; ++jj) { const int t0 = (tid + 512 * jj) * 8;
                float a[8], b[8], a2[8], b2[8];
                conv8(sx, t0, SEQ, wx0, wx1, wx2, cbx, a); conv8(sv, t0, SEQ, wv0, wv1, wv2, cbv, a2);
                conv8(sx + SEQ, t0, SEQ, wx0, wx1, wx2, cbx, b); conv8(sv + SEQ, t0, SEQ, wv0, wv1, wv2, cbv, b2);
                const int ad = (t0 >> 7) * 129 + (t0 & 127);
#pragma unroll
                for (int e = 0; e < 8; ++e) lds[ad + e] = (f2_t){a[e] * a2[e], b[e] * b2[e]}; }
            __syncthreads();
            fft_pass<1, false, 1>(lds, tid, nullptr, nullptr, 0.f); fft_pass<2, false, 0>(lds, tid, nullptr, nullptr, 0.f); fft_pass<3, false, 0>(lds, tid, nullptr, nullptr, 0.f);
            fft_pass<4, false, 2>(lds, tid, kscr, nullptr, 0.f);
            fft_pass<4, true, 0>(lds, tid, nullptr, nullptr, 0.f); fft_pass<3, true, 0>(lds, tid, nullptr, nullptr, 0.f); fft_pass<2, true, 0>(lds, tid, nullptr, nullptr, 0.f);
            fft_pass<1, true, 4>(lds, tid, nullptr, nullptr, 0.f);
#pragma unroll
            for (int jj = 0; jj < 2; ++jj) { const int t0 = (tid + 512 * jj) * 8;
                float a[8], b[8], a2[8], b2[8];
                conv8(sx, t0, SEQ, wx0, wx1, wx2, cbx, a); conv8(sv, t0, SEQ, wv0, wv1, wv2, cbv, a2);
                conv8(sx + SEQ, t0, SEQ, wx0, wx1, wx2, cbx, b); conv8(sv + SEQ, t0, SEQ, wv0, wv1, wv2, cbv, b2);
                const int ad = (t0 >> 7) * 129 + (t0 & 127);
#pragma unroll
                for (int e = 0; e < 8; ++e) { const f2_t v = lds[ad + e]; a[e] = v.x + a[e] * a2[e] * skip; b[e] = v.y + b[e] * b2[e] * skip; }
                *(u32x4*)(u0 + t0) = pack8(a); *(u32x4*)(u1 + t0) = pack8(b); }
        }
        __syncthreads();
        {
            float* kcs = (float*)shm; float* usm = kcs + 512;
            const float* kcc = (const float*)(ws + OFF_KCUC) + (size_t)c * 512;
            const float inrm = 1.f / nrm[1024 + c];
            for (int i = tid; i < 512; i += 512) kcs[i] = kcc[i] * inrm;
            bf16_t* utc = (bf16_t*)(ws + OFF_UTC);
#pragma unroll
            for (int i = tid; i < 2048; i += 512) { const int b = i >> 8, t = i & 255; const bf16_t* qx = x1r + TX + b * CL; const bf16_t* qv = vr + TX + b * CL;
                const float xl = t > 0 ? bf1(qx[t - 1]) : 0.f, xr = t < CL - 1 ? bf1(qx[t + 1]) : 0.f, vl = t > 0 ? bf1(qv[t - 1]) : 0.f, vrr = t < CL - 1 ? bf1(qv[t + 1]) : 0.f;
                usm[i] = (cbx + wx0 * xl + wx1 * bf1(qx[t]) + wx2 * xr) * (cbv + wv0 * vl + wv1 * bf1(qv[t]) + wv2 * vrr); }
            __syncthreads();
            const int b = wid;
            float acc[4] = {0.f, 0.f, 0.f, 0.f};
            float ur[4];
#pragma unroll
            for (int k = 0; k < 4; ++k) ur[k] = usm[b * 256 + 64 * k + lane];
#pragma unroll 4
            for (int sl = 0; sl < 64; ++sl) {
                float kv[7];
#pragma unroll
                for (int d = 0; d < 7; ++d) kv[d] = kcs[(lane - sl + 64 * (d - 3)) & 511];
                float uk[4];
#pragma unroll
                for (int k = 0; k < 4; ++k) uk[k] = __builtin_bit_cast(float, __builtin_amdgcn_readlane(__builtin_bit_cast(int, ur[k]), sl));
#pragma unroll
                for (int jj = 0; jj < 4; ++jj)
#pragma unroll
                    for (int k = 0; k < 4; ++k) acc[jj] += uk[k] * kv[jj - k + 3];
            }
#pragma unroll
            for (int jj = 0; jj < 4; ++jj) { const int t = lane + 64 * jj; utc[((size_t)(b * DM + c)) * CL + t] = f2bf(acc[jj] + usm[b * 256 + t] * skip); }
        }
    }
    __syncthreads();
}

DI void kprep_phase(const P& p) {
    const int tid = otid(); const int lane = tid & 63, wid = tid >> 6;
    const int gw = blockIdx.x * 8 + wid, NGW = gridDim.x * 8;
    bf16_t* qkv = (bf16_t*)(p.ws + OFF_BIG);
    const int j = lane & 7, hk = (lane >> 3) & 3, rsel = lane >> 5;
    float kn[8], inv[8];
#pragma unroll
    for (int e = 0; e < 8; ++e) { kn[e] = p.at_k_norm[8 * j + e];
        inv[e] = __builtin_amdgcn_exp2f(-(float)(8 * (j & 1) + e) * (13.287712379549449f / 16.f)) * 0.15915494309189535f; }
    const bool rowax = j < 4, hi = (j & 2) != 0;
    for (int it0 = gw; 2 * it0 < TT; it0 += 2 * NGW) {
        u32x4 w[2];
#pragma unroll
        for (int rr = 0; rr < 2; ++rr) { const int row = 2 * (it0 + rr * NGW) + rsel;
            w[rr] = (row < TT) ? *(const u32x4*)(qkv + (size_t)row * 1536 + 1024 + hk * 64 + 8 * j) : (u32x4){0u, 0u, 0u, 0u}; }
#pragma unroll
        for (int rr = 0; rr < 2; ++rr) { const int row = 2 * (it0 + rr * NGW) + rsel; const bool lat = row < TX;
            float x[8]; unpack8(w[rr], x);
            float ss = 0.f;
#pragma unroll
            for (int e = 0; e < 8; ++e) ss += x[e] * x[e];
            ss += dpp_mov<0xB1>(ss); ss += dpp_mov<0x4E>(ss); ss += dpp_mov<0x141>(ss);
            const float rs = __builtin_amdgcn_rsqf(ss * (1.f / 64.f) + EPS);
            const int t = row & (SEQ - 1); const float pos = (float)(rowax ? (t >> 6) : (t & 63));
#pragma unroll
            for (int e = 0; e < 8; ++e) { float y = x[e] * rs * kn[e];
                const float pr = dpp_mov<0x4E>(y);
                const float turns = pos * inv[e]; const float cs = __builtin_amdgcn_cosf(turns), sn = __builtin_amdgcn_sinf(turns);
                if (lat) y = hi ? (y * cs + pr * sn) : (y * cs - pr * sn);
                x[e] = y; }
            if (row < TT) *(u32x4*)(qkv + (size_t)row * 1536 + 1024 + hk * 64 + 8 * j) = pack8(x); }
    }
}

DI void attn_stage_load(const bf16_t* qkv, int rowk, int g, int tid, u32x4 (&kr)[2], u32x4 (&vr)[2]) {
    { const int key = tid >> 2, c4 = tid & 3; const bf16_t* src = qkv + (size_t)(rowk + key) * 1536 + 1024 + g * 64 + c4 * 16; kr[0] = *(const u32x4*)src; kr[1] = *(const u32x4*)(src + 8); }
    { const int key = tid & 127, dg = tid >> 7; const bf16_t* src = qkv + (size_t)(rowk + key) * 1536 + 1280 + g * 64 + dg * 8; vr[0] = *(const u32x4*)src; vr[1] = *(const u32x4*)(src + 32); }
}
DI void attn_stage_store(bf16_t* Ks, bf16_t* Vt, int tid, const u32x4 (&kr)[2], const u32x4 (&vr)[2]) {
    { const int key = tid >> 2, c4 = tid & 3; *(u32x4*)(Ks + key * 72 + c4 * 16) = kr[0]; *(u32x4*)(Ks + key * 72 + c4 * 16 + 8) = kr[1]; }
    { const int key = tid & 127, dg = tid >> 7;
#pragma unroll
        for (int hf = 0; hf < 2; ++hf) { const int d0 = hf * 32 + dg * 8; const u32x4 w = vr[hf];
            Vt[(d0 + 0) * 132 + key] = (bf16_t)(w.x & 0xffff); Vt[(d0 + 1) * 132 + key] = (bf16_t)(w.x >> 16);
            Vt[(d0 + 2) * 132 + key] = (bf16_t)(w.y & 0xffff); Vt[(d0 + 3) * 132 + key] = (bf16_t)(w.y >> 16);
            Vt[(d0 + 4) * 132 + key] = (bf16_t)(w.z & 0xffff); Vt[(d0 + 5) * 132 + key] = (bf16_t)(w.z >> 16);
            Vt[(d0 + 6) * 132 + key] = (bf16_t)(w.w & 0xffff); Vt[(d0 + 7) * 132 + key] = (bf16_t)(w.w >> 16); } }
}
DI void attn_phase(const P& p, unsigned char* shm) {
    const int tid = otid(), lane = tid & 63, wid = tid >> 6, r = lane & 31, h = lane >> 5;
    constexpr int BUFB = 18432 + 16896;
    const bf16_t* qkv = (const bf16_t*)(p.ws + OFF_BIG);
    bf16_t* obuf = (bf16_t*)(p.ws + OFF_HBUF);
    float mq = fabsf(p.at_q_norm[lane]), mk = fabsf(p.at_k_norm[lane]);
#pragma unroll
    for (int o = 1; o < 64; o <<= 1) { mq = fmaxf(mq, __shfl_xor(mq, o)); mk = fmaxf(mk, __shfl_xor(mk, o)); }
    const float negB = -(8.f * LOG2E) * mq * mk;
    for (int unit = blockIdx.x; unit < 2048; unit += gridDim.x) {
        const int qb = unit & 63, g = (unit >> 6) & 3, b = unit >> 8;
        const int q0 = qb * 128, hd = g * 4 + (wid >> 1), woff = (wid & 1) * 64, qs = q0 + woff;
        bf16x8 qf[2][4];
        int hq = h; asm volatile("" : "+v"(hq));
#pragma unroll
        for (int m = 0; m < 2; ++m) {
            const int t = qs + 32 * m + r;
            float x[4][8]; float ss = 0.f;
#pragma unroll
            for (int s = 0; s < 4; ++s) { unpack8(*(const u32x4*)(qkv + (size_t)(b * SEQ + t) * 1536 + hd * 64 + 16 * s + 8 * h), x[s]);
#pragma unroll
                for (int e = 0; e < 8; ++e) ss += x[s][e] * x[s][e]; }
            ss += __shfl_xor(ss, 32);
            const float rs = __builtin_amdgcn_rsqf(ss * (1.f / 64.f) + EPS);
            const float rsq = rs * (0.125f * LOG2E);
#pragma unroll
            for (int s = 0; s < 4; ++s) { const f32x4 g0 = *(const f32x4*)(p.at_q_norm + 16 * s + 8 * hq), g1 = *(const f32x4*)(p.at_q_norm + 16 * s + 8 * hq + 4);
                x[s][0] *= rsq * g0.x; x[s][1] *= rsq * g0.y; x[s][2] *= rsq * g0.z; x[s][3] *= rsq * g0.w; x[s][4] *= rsq * g1.x; x[s][5] *= rsq * g1.y; x[s][6] *= rsq * g1.z; x[s][7] *= rsq * g1.w; }
#pragma unroll
            for (int ax = 0; ax < 2; ++ax) { const float pos = (float)(ax == 0 ? (t >> 6) : (t & 63));
#pragma unroll
                for (int e = 0; e < 8; ++e) { const float turns = pos * (__builtin_amdgcn_exp2f(-(float)(8 * hq + e) * (13.287712379549449f / 16.f)) * 0.15915494309189535f); const float cs = __builtin_amdgcn_cosf(turns), sn = __builtin_amdgcn_sinf(turns);
                    const float x1 = x[2 * ax][e], x2 = x[2 * ax + 1][e];
                    x[2 * ax][e] = x1 * cs - x2 * sn; x[2 * ax + 1][e] = x2 * cs + x1 * sn; } }
#pragma unroll
            for (int s = 0; s < 4; ++s) qf[m][s] = __builtin_bit_cast(bf16x8, pack8(x[s]));
        }
        f32x16 o[2][2];
#pragma unroll
        for (int m = 0; m < 2; ++m)
#pragma unroll
            for (int d = 0; d < 2; ++d)
#pragma unroll
                for (int i = 0; i < 16; ++i) o[m][d][i] = 0.f;
        float lrun[2] = {0.f, 0.f};
        const int ch0 = (q0 == 0) ? 1 : 0;
        auto chunk_row = [&](int ch) { return (ch < 3) ? (b * SEQ + q0 - 128 + 128 * ch) : (TX + b * CL + (ch - 3) * 128); };
        auto chunk_next = [&](int ch) { int n = ch + 1; if (n == 2 && q0 + 128 >= SEQ) n = 3; return n; };
        u32x4 kr[2], vr[2];
        attn_stage_load(qkv, chunk_row(ch0), g, tid, kr, vr);
        attn_stage_store((bf16_t*)shm, (bf16_t*)(shm + 18432), tid, kr, vr);
        __syncthreads();
        int buf = 0;
        for (int ch = ch0; ch < 5; ) {
            const int nch = chunk_next(ch);
            if (nch < 5) attn_stage_load(qkv, chunk_row(nch), g, tid, kr, vr);
            const bf16_t* Ks = (const bf16_t*)(shm + buf * BUFB); const bf16_t* Vt = (const bf16_t*)(shm + buf * BUFB + 18432);
#pragma unroll
            for (int m = 0; m < 2; ++m) {
                const int dk = (woff + 32 * m) >> 5;
                const int kt_lo = (ch == 0) ? dk : 0, kt_hi = (ch == 2) ? dk : 3;
                for (int kt = kt_lo; kt <= kt_hi; ++kt) {
                    f32x16 sa;
#pragma unroll
                    for (int i = 0; i < 16; ++i) sa[i] = negB;
#pragma unroll
                    for (int s = 0; s < 4; ++s) { const bf16x8 a = *(const bf16x8*)(Ks + (kt * 32 + r) * 72 + 16 * s + 8 * h); sa = __builtin_amdgcn_mfma_f32_32x32x16_bf16(a, qf[m][s], sa, 0, 0, 0); }
                    float psum = 0.f;
                    if ((ch == 0 || ch == 2) && kt == dk) {
#pragma unroll
                        for (int i = 0; i < 16; ++i) { const int kk = (i & 3) + 8 * (i >> 2) + 4 * h; const bool ok = (ch == 0) ? (kk >= r) : (kk <= r); const float pv = ok ? __builtin_amdgcn_exp2f(sa[i]) : 0.f; psum += pv; sa[i] = pv; }
                    } else {
#pragma unroll
                        for (int i = 0; i < 16; ++i) { const float pv = __builtin_amdgcn_exp2f(sa[i]); psum += pv; sa[i] = pv; }
                    }
                    lrun[m] += psum;
                    bf16x8 pf[2];
#pragma unroll
                    for (int s2 = 0; s2 < 2; ++s2) { u32x4 w; w.x = pk2(sa[8 * s2], sa[8 * s2 + 1]); w.y = pk2(sa[8 * s2 + 2], sa[8 * s2 + 3]); w.z = pk2(sa[8 * s2 + 4], sa[8 * s2 + 5]); w.w = pk2(sa[8 * s2 + 6], sa[8 * s2 + 7]);
                        pf[s2] = __builtin_bit_cast(bf16x8, w); }
#pragma unroll
                    for (int s2 = 0; s2 < 2; ++s2)
#pragma unroll
                        for (int d = 0; d < 2; ++d) {
                            const bf16_t* vp = Vt + (d * 32 + r) * 132 + kt * 32 + 16 * s2 + 4 * h;
                            const s16x4 lo = *(const s16x4*)vp, hi = *(const s16x4*)(vp + 8);
                            const bf16x8 av = __builtin_shufflevector(lo, hi, 0, 1, 2, 3, 4, 5, 6, 7);
                            o[m][d] = __builtin_amdgcn_mfma_f32_32x32x16_bf16(av, pf[s2], o[m][d], 0, 0, 0);
                        }
                }
            }
            if (nch < 5) attn_stage_store((bf16_t*)(shm + (buf ^ 1) * BUFB), (bf16_t*)(shm + (buf ^ 1) * BUFB + 18432), tid, kr, vr);
            __syncthreads();
            buf ^= 1; ch = nch;
        }
        const float sinkp = __builtin_amdgcn_exp2f(p.at_sink[hd] * LOG2E + negB);
#pragma unroll
        for (int m = 0; m < 2; ++m) {
            const float il = 1.f / (lrun[m] + __shfl_xor(lrun[m], 32) + sinkp);
            bf16_t* orow = obuf + (size_t)(b * SEQ + qs + 32 * m + r) * DM + hd * 64;
#pragma unroll
            for (int d = 0; d < 2; ++d)
#pragma unroll
                for (int gq = 0; gq < 4; ++gq) { u32x2 w; w.x = pk2(o[m][d][4 * gq] * il, o[m][d][4 * gq + 1] * il); w.y = pk2(o[m][d][4 * gq + 2] * il, o[m][d][4 * gq + 3] * il);
                    *(u32x2*)(orow + d * 32 + 8 * gq + 4 * h) = w; }
        }
    }
    __syncthreads();
}

__global__ void __launch_bounds__(512, 2) fwd_megakernel(P p) {
    extern __shared__ __attribute__((aligned(16))) unsigned char shm[];
    cg::grid_group grid = cg::this_grid();
    unsigned char* ws = p.ws;
    bf16_t* hbuf = (bf16_t*)(ws + OFF_HBUF);
    bf16_t* big = (bf16_t*)(ws + OFF_BIG);
    float* cx = (float*)(ws + OFF_CX);
    const float* modv = (const float*)(ws + OFF_MOD);

#ifndef PHASE_MASK
#define PHASE_MASK 0xffffffffu
#endif
#ifndef DUP_MASK
#define DUP_MASK 0u
#endif
#define PH(n) for (int _rep = 0; _rep < (((DUP_MASK >> (n)) & 1u) ? 2 : 1); ++_rep) if ((PHASE_MASK >> (n)) & 1u)
    if (blockIdx.x == 0) { unsigned* z = (unsigned*)(ws + OFF_NORM); for (int i = threadIdx.x; i < 8192; i += 512) z[i] = 0u; }
    PH(0) phase0(p, shm);
    grid.sync();
    if (threadIdx.x == 0) { *(volatile LAS unsigned*)(LAS unsigned char*)(shm + LDS_XB) = 0u; *((volatile LAS unsigned*)(LAS unsigned char*)(shm + LDS_XB) + 1) = 0u; }
    __syncthreads();
    const XcdBarrier xb = xcd_barrier_post((unsigned*)(ws + OFF_XBAR), (volatile LAS unsigned*)(LAS unsigned char*)(shm + LDS_XB));
    PH(1) kcgen_phase(p, shm);
    PH(1) sw_phase(p, shm);
    PH(2) norm_phase(p.x, p.ctx, p.norm1_w, modv, 0, 1, hbuf, TT, shm);
    xcd_barrier(xb);
    float* ssq = (float*)(ws + OFF_SSQ); float* ssp = (float*)(ws + OFF_SSQP); const float* swv = (const float*)(ws + OFF_SW);
    bf16_t* xgA = (bf16_t*)(ws + OFF_UT);
    const float* modv1 = modv + 9 * 6144;
    PH(3) { pg8::EpiBf16RowBias E; E.O = big; E.ldc = TT; E.bias = p.hy_b_in; run_gemm(shm, (const bf16_t*)(ws + OFF_WIN), hbuf, 3072, TT, DM, E); }
    xcd_barrier(xb);
    PH(5) fftconv_phase(p, shm);
    xcd_barrier(xb);
    PH(6) zback_phase(p, shm);
    xcd_barrier(xb);
    bf16_t* resid = (bf16_t*)p.out;
    bf16_t* cxb = (bf16_t*)cx;
    PH(7) { pg8::EpiRes<true, false, true> E; E.srcX = p.x; E.srcC = p.ctx; E.dstX = resid; E.dstC = cxb; E.bias = p.hy_b_out; E.gate = modv + 2 * 1024;
            E.xg = xgA; E.gw = p.norm2_w; E.scl = modv + 4 * 1024; E.ssq = ssp; run_gemm(shm, hbuf, (const bf16_t*)(ws + OFF_WHO), TX, DM, DM, E);
            pg8::EpiPartial Ep; Ep.part = (float*)(ws + OFF_BIG); Ep.ksplit = 4; Ep.slice = (size_t)TC * DM;
            run_gemm(shm, hbuf + (size_t)TX * DM, (const bf16_t*)(ws + OFF_WHO), TC, DM, DM / 4, Ep, DM, 4); }
    xcd_barrier(xb);
    rnorm_phase(ssp, ssq, TX);
    ctx_finalize((const float*)(ws + OFF_BIG), 4, p.ctx, p.hy_b_out, cxb, modv + 8 * 6144 + 2 * 1024, p.norm2_w, modv + 8 * 6144 + 4 * 1024, xgA + (size_t)TX * DM, ssq + TX);
    xcd_barrier(xb);
    PH(9) { pg8::EpiBf16<1, true> E; E.O = big; E.ldc = DFF; E.bias = nullptr; E.ssq = ssq; E.sw = swv; run_gemm(shm, xgA, (const bf16_t*)(ws + OFF_W1), TT, DFF, DM, E); }
    xcd_barrier(xb);
    PH(10) { pg8::EpiRes<true, true, true> E; E.srcX = resid; E.srcC = cxb; E.dstX = resid; E.dstC = cxb; E.bias = nullptr; E.gate = modv + 5 * 1024;
             E.xg = hbuf; E.gw = p.norm1_w + DM; E.scl = modv1 + 1 * 1024; E.ssq = ssp + (size_t)TT * 16; run_gemm(shm, big, (const bf16_t*)(ws + OFF_W2), TX, DM, DFF, E);
             pg8::EpiPartial Ep; Ep.part = (float*)(ws + OFF_UT); Ep.ksplit = 8; Ep.slice = (size_t)TC * DM;
             run_gemm(shm, big + (size_t)TX * DFF, (const bf16_t*)(ws + OFF_W2), TC, DM, DFF / 8, Ep, DFF, 8); }
    xcd_barrier(xb);
    rnorm_phase(ssp + (size_t)TT * 16, ssq + TT, TX);
    ctx_finalize((const float*)(ws + OFF_UT), 8, nullptr, nullptr, cxb, modv + 8 * 6144 + 5 * 1024, p.norm1_w + DM, modv1 + 8 * 6144 + 1 * 1024, hbuf + (size_t)TX * DM, ssq + TT + TX);
    xcd_barrier(xb);
    PH(12) { pg8::EpiBf16<0, true> E; E.O = big; E.ldc = 1536; E.bias = p.at_b_qkv; E.ssq = ssq + TT; E.sw = swv + 9 * 4096; run_gemm(shm, hbuf, (const bf16_t*)(ws + OFF_WQKV), TT, 1536, DM, E); }
    xcd_barrier(xb);
    PH(13) kprep_phase(p);
    xcd_barrier(xb);
    PH(14) attn_phase(p, shm);
    xcd_barrier(xb);
    bf16_t* xgB = (bf16_t*)((char*)p.out + 128 * MiB);
    PH(15) { pg8::EpiRes<true, true, true> E; E.srcX = resid; E.srcC = cxb; E.dstX = xgA; E.dstC = cxb; E.bias = p.at_b_out; E.gate = modv1 + 2 * 1024;
             E.xg = xgB; E.gw = p.norm2_w + DM; E.scl = modv1 + 4 * 1024; E.ssq = ssp + (size_t)2 * TT * 16; run_gemm(shm, hbuf, (const bf16_t*)(ws + OFF_WAO), TX, DM, DM, E); }
    xcd_barrier(xb);
    rnorm_phase(ssp + (size_t)2 * TT * 16, ssq + 2 * TT, TX);
    xcd_barrier(xb);
    PH(17) { pg8::EpiBf16<1, true> E; E.O = big; E.ldc = DFF; E.bias = nullptr; E.ssq = ssq + 2 * TT; E.sw = swv + 2 * 9 * 4096; run_gemm(shm, xgB, (const bf16_t*)(ws + OFF_W1) + (size_t)DM * DFF, TX, DFF, DM, E); }
    xcd_barrier(xb);
    PH(18) { pg8::EpiRes<false, true, false> E; E.srcX = xgA; E.srcC = cxb; E.dstX = p.out; E.dstC = cx; E.bias = nullptr; E.gate = modv1 + 5 * 1024;
             E.xg = nullptr; E.gw = nullptr; E.scl = nullptr; E.ssq = nullptr; run_gemm(shm, big, (const bf16_t*)(ws + OFF_W2) + (size_t)DM * DFF, TX, DM, DFF, E); }
}

extern "C" void kernel_launch(void* const* d_in, const int* in_sizes, int n_in, void* d_out, int out_size, void* d_ws, size_t ws_size, hipStream_t stream) {
    static int grid_blocks = 0;
    if (grid_blocks == 0) {
        if (n_in != 31 || ws_size < WS_END) { fprintf(stderr, "kernel_launch: unexpected n_in %d or ws_size %zu (< %zu)\n", n_in, ws_size, (size_t)WS_END); grid_blocks = -1; return; }
        int dev = 0, cus = 0, per_cu = 0;
        hipGetDevice(&dev);
        hipDeviceGetAttribute(&cus, hipDeviceAttributeMultiprocessorCount, dev);
        if (hipFuncSetAttribute((const void*)fwd_megakernel, hipFuncAttributeMaxDynamicSharedMemorySize, LDS_BYTES) != hipSuccess) { fprintf(stderr, "kernel_launch: hipFuncSetAttribute failed\n"); }
        hipOccupancyMaxActiveBlocksPerMultiprocessor(&per_cu, (const void*)fwd_megakernel, 512, LDS_BYTES);
        if (per_cu < 1) { fprintf(stderr, "kernel_launch: occupancy query gave %d\n", per_cu); per_cu = 1; }
        if (per_cu > 1) per_cu = 1;
        (void)hipGetLastError();
        grid_blocks = cus * per_cu;
    }
    if (grid_blocks < 0) return;
    P p{};
    const float** pp = (const float**)&p;
    for (int i = 0; i < 31; ++i) pp[i] = (const float*)d_in[i];
    p.out = (float*)d_out; p.ws = (unsigned char*)d_ws;
    void* args[] = {&p};
    hipError_t e = hipLaunchCooperativeKernel((const void*)fwd_megakernel, dim3(grid_blocks), dim3(512), args, LDS_BYTES, stream);
    if (e != hipSuccess) fprintf(stderr, "cooperative launch failed: %s (grid %d)\n", hipGetErrorString(e), grid_blocks);
}
```
